# Optimizing an MI355X kernel written in HIP

```python
import math
import jax, jax.numpy as jnp
from jax import lax
import numpy as np

D_MODEL = 1024
BATCH = 4
SEQ = 4096
DEPTH = 4
DEC_BATCH = 8
DEC_SEQ = 4096
PAST_LEN = 128

N_MIXERS = 2
N_POOL_LAYERS = (DEPTH + 1) // 2
N_ATTN_LAYERS = DEPTH // 2
POOL_WINDOWS = (2, 4, 8, 16)
N_POOL_GROUPS = len(POOL_WINDOWS)
POOL_GROUP_DIM = D_MODEL // N_POOL_GROUPS
HEAD_DIM = 128
N_HEADS = D_MODEL // HEAD_DIM
N_KV_HEADS = 2
GQA_GROUP = N_HEADS // N_KV_HEADS
QKV_DIM = (N_HEADS + 2 * N_KV_HEADS) * HEAD_DIM
ROPE_AXIS_DIM = HEAD_DIM // 2
ROPE_THETA = 10000.0
GRID_W = 64
Q_BLOCK = 128
D_FF = int(math.ceil(8 * D_MODEL / 3 / 256) * 256)
EPS = 1e-6

kernel_name = "hybrid_pool_gqa_axialrope_encoder"


def rms_norm(x, g):
    xf = x.astype(jnp.float32)
    y = xf * lax.rsqrt(jnp.mean(xf * xf, axis=-1, keepdims=True) + EPS)
    return (y * g.astype(jnp.float32)).astype(x.dtype)


def pool_mixer(h, w_pool, b_pool, scale):
    B, T, D = h.shape
    hf = h.astype(jnp.float32)
    cs = jnp.concatenate([jnp.zeros((B, 1, D), jnp.float32), jnp.cumsum(hf, axis=1)], axis=1)
    t = jnp.arange(T, dtype=jnp.int32)
    outs = []
    for gi, w in enumerate(POOL_WINDOWS):
        sl = slice(gi * POOL_GROUP_DIM, (gi + 1) * POOL_GROUP_DIM)
        lo = jnp.maximum(t - w // 2, 0)
        hi = jnp.minimum(t + w // 2, T)
        csg = cs[:, :, sl]
        window_sum = jnp.take(csg, hi, axis=1) - jnp.take(csg, lo, axis=1)
        count = (hi - lo).astype(jnp.float32)[None, :, None]
        pooled = window_sum / count - hf[:, :, sl]
        y = jnp.einsum('btc,cd->btd', pooled, w_pool[gi].astype(jnp.float32)) + b_pool[gi].astype(jnp.float32)
        outs.append(y)
    y = jnp.concatenate(outs, axis=-1) * scale.astype(jnp.float32)
    return y.astype(h.dtype)


def axial_rope_tables(T):
    rows = T // GRID_W
    rr, cc = jnp.meshgrid(jnp.arange(rows, dtype=jnp.float32), jnp.arange(GRID_W, dtype=jnp.float32), indexing='ij')
    row = rr.reshape(-1)
    col = cc.reshape(-1)
    inv_freq = ROPE_THETA ** (-jnp.arange(0, ROPE_AXIS_DIM, 2, dtype=jnp.float32) / ROPE_AXIS_DIM)
    ang_r = row[:, None] * inv_freq[None, :]
    ang_c = col[:, None] * inv_freq[None, :]
    ang_r = jnp.concatenate([ang_r, ang_r], axis=-1)
    ang_c = jnp.concatenate([ang_c, ang_c], axis=-1)
    return jnp.cos(ang_r), jnp.sin(ang_r), jnp.cos(ang_c), jnp.sin(ang_c)


def rotate_half(x):
    x1, x2 = jnp.split(x, 2, axis=-1)
    return jnp.concatenate([-x2, x1], axis=-1)


def apply_axial_rope(x, tables):
    cos_r, sin_r, cos_c, sin_c = tables
    xf = x.astype(jnp.float32)
    xr, xc = xf[..., :ROPE_AXIS_DIM], xf[..., ROPE_AXIS_DIM:]
    cr, sr = cos_r[None, :, None, :], sin_r[None, :, None, :]
    cc, sc = cos_c[None, :, None, :], sin_c[None, :, None, :]
    yr = xr * cr + rotate_half(xr) * sr
    yc = xc * cc + rotate_half(xc) * sc
    return jnp.concatenate([yr, yc], axis=-1).astype(x.dtype)


def attention_mixer(h, w_qkv, q_gain, k_gain, w_o):
    B, T, D = h.shape
    qkv = jnp.einsum('btd,de->bte', h, w_qkv)
    q = qkv[..., :N_HEADS * HEAD_DIM].reshape(B, T, N_HEADS, HEAD_DIM)
    k = qkv[..., N_HEADS * HEAD_DIM:(N_HEADS + N_KV_HEADS) * HEAD_DIM].reshape(B, T, N_KV_HEADS, HEAD_DIM)
    v = qkv[..., (N_HEADS + N_KV_HEADS) * HEAD_DIM:].reshape(B, T, N_KV_HEADS, HEAD_DIM)
    q = rms_norm(q, q_gain)
    k = rms_norm(k, k_gain)
    tables = axial_rope_tables(T)
    q = apply_axial_rope(q, tables)
    k = apply_axial_rope(k, tables)
    n_blk = T // Q_BLOCK
    qb = q.reshape(B, n_blk, Q_BLOCK, N_KV_HEADS, GQA_GROUP, HEAD_DIM).transpose(1, 0, 2, 3, 4, 5)
    scale = 1.0 / math.sqrt(HEAD_DIM)

    def one_block(q_blk):
        s = jnp.einsum('bqkgd,bskd->bkgqs', q_blk, k).astype(jnp.float32) * scale
        p = jax.nn.softmax(s, axis=-1)
        return jnp.einsum('bkgqs,bskd->bqkgd', p.astype(v.dtype), v)

    o = lax.map(one_block, qb)
    o = o.transpose(1, 0, 2, 3, 4, 5).reshape(B, T, N_HEADS * HEAD_DIM)
    return jnp.einsum('bte,ed->btd', o, w_o)


def swiglu_ffn(h, w_gate_up, w_down):
    gu = jnp.einsum('btd,df->btf', h, w_gate_up)
    g, u = gu[..., :D_FF], gu[..., D_FF:]
    return jnp.einsum('btf,fd->btd', jax.nn.silu(g) * u, w_down)


def trunk(x, norm_mix, norm_ffn, pool_w, pool_b, pool_scale,
          attn_w_qkv, attn_q_gain, attn_k_gain, attn_w_o, ffn_w_gate_up, ffn_w_down):
    for i in range(DEPTH):
        h = rms_norm(x, norm_mix[i])
        j = i // N_MIXERS
        if i % N_MIXERS == 0:
            x = x + pool_mixer(h, pool_w[j], pool_b[j], pool_scale[j])
        else:
            x = x + attention_mixer(h, attn_w_qkv[j], attn_q_gain[j], attn_k_gain[j], attn_w_o[j])
        h = rms_norm(x, norm_ffn[i])
        x = x + swiglu_ffn(h, ffn_w_gate_up[i], ffn_w_down[i])
    return x


def setup_inputs(seed: int = 0) -> dict:
    key = jax.random.key(seed)
    ks = jax.random.split(key, 16)
    f32 = jnp.float32
    nrm = lambda k, shape, s: jax.random.normal(k, shape, f32) * s
    return {
        "x_prompt": nrm(ks[0], (BATCH, SEQ, D_MODEL), 1.0),
        "x_sample": nrm(ks[1], (DEC_BATCH, DEC_SEQ, D_MODEL), 1.0),
        "norm_mix": 1.0 + nrm(ks[2], (DEPTH, D_MODEL), 0.05),
        "norm_ffn": 1.0 + nrm(ks[3], (DEPTH, D_MODEL), 0.05),
        "pool_w": nrm(ks[4], (N_POOL_LAYERS, N_POOL_GROUPS, POOL_GROUP_DIM, POOL_GROUP_DIM), POOL_GROUP_DIM ** -0.5),
        "pool_b": nrm(ks[5], (N_POOL_LAYERS, N_POOL_GROUPS, POOL_GROUP_DIM), 0.02),
        "pool_scale": 1.0 + nrm(ks[6], (N_POOL_LAYERS, D_MODEL), 0.1),
        "attn_w_qkv": nrm(ks[7], (N_ATTN_LAYERS, D_MODEL, QKV_DIM), D_MODEL ** -0.5),
        "attn_q_gain": 1.0 + nrm(ks[8], (N_ATTN_LAYERS, HEAD_DIM), 0.05),
        "attn_k_gain": 1.0 + nrm(ks[9], (N_ATTN_LAYERS, HEAD_DIM), 0.05),
        "attn_w_o": nrm(ks[10], (N_ATTN_LAYERS, N_HEADS * HEAD_DIM, D_MODEL), (N_HEADS * HEAD_DIM) ** -0.5),
        "ffn_w_gate_up": nrm(ks[11], (DEPTH, D_MODEL, 2 * D_FF), D_MODEL ** -0.5),
        "ffn_w_down": nrm(ks[12], (DEPTH, D_FF, D_MODEL), D_FF ** -0.5),
    }


def reference(x_prompt, x_sample, norm_mix, norm_ffn, pool_w, pool_b, pool_scale,
              attn_w_qkv, attn_q_gain, attn_k_gain, attn_w_o, ffn_w_gate_up, ffn_w_down):
    y_prompt = trunk(x_prompt, norm_mix, norm_ffn, pool_w, pool_b, pool_scale,
                     attn_w_qkv, attn_q_gain, attn_k_gain, attn_w_o, ffn_w_gate_up, ffn_w_down)
    y_sample = trunk(x_sample, norm_mix, norm_ffn, pool_w, pool_b, pool_scale,
                     attn_w_qkv, attn_q_gain, attn_k_gain, attn_w_o, ffn_w_gate_up, ffn_w_down)
    return (y_prompt, y_sample)
```

```cpp
#include <hip/hip_runtime.h>
#include <hip/hip_bf16.h>
#include <hip/hip_cooperative_groups.h>
#include <cstdio>
#include <cstdint>
namespace cg = cooperative_groups;

#ifndef MK_N_LAUNCHES
#define MK_N_LAUNCHES 1
#endif

constexpr int DM = 1024, SEQ = 4096, NB_TOT = 12, M_TOT = NB_TOT * SEQ;
constexpr int DFF = 2816, NGU = 2 * DFF, NQKV = 1536, HD = 128;
constexpr float EPS = 1e-6f;
constexpr int N_PHASES = 19;

constexpr size_t MiB = 1u << 20;
constexpr size_t WS_ROPE = 0;
constexpr size_t WS_BOUND = 32768;
constexpr size_t WS_BAR = 2 * MiB - 65536;
constexpr size_t WS_WGU = 2 * MiB;
constexpr size_t WS_WD = 46 * MiB;
constexpr size_t WS_WQKV = 68 * MiB;
constexpr size_t WS_WO = 74 * MiB;
constexpr size_t WS_WP = 78 * MiB;
constexpr size_t WS_XB = 80 * MiB;
constexpr size_t WS_H = 176 * MiB;
constexpr size_t WS_QKV = 176 * MiB;
constexpr size_t WS_KC = 272 * MiB;
constexpr size_t WS_VC = 296 * MiB;
constexpr size_t WS_O = 320 * MiB;
constexpr size_t WS_P = 176 * MiB;
constexpr size_t WS_SS = 440 * MiB;
constexpr size_t WS_END = 444 * MiB;
static_assert(WS_ROPE + 64 * 32 * 8 <= WS_BAR && WS_BAR + 16384 <= WS_WGU && WS_WGU + (size_t)4 * NGU * DM * 2 <= WS_WD && WS_WD + (size_t)4 * DM * DFF * 2 <= WS_WQKV, "ws map 1");
static_assert(WS_WQKV + (size_t)2 * NQKV * DM * 2 <= WS_WO && WS_WO + (size_t)2 * DM * DM * 2 <= WS_WP && WS_WP + (size_t)2 * DM * 256 * 2 <= WS_XB, "ws map 2");
static_assert(WS_XB + (size_t)M_TOT * DM * 2 <= WS_H && WS_H + (size_t)M_TOT * DFF * 2 <= WS_SS && WS_SS + (size_t)8 * M_TOT * 8 <= WS_END && WS_QKV + (size_t)M_TOT * DM * 2 <= WS_KC && WS_KC + (size_t)M_TOT * 256 * 2 <= WS_VC && WS_VC + (size_t)M_TOT * 256 * 2 <= WS_O && WS_O + (size_t)M_TOT * DM * 2 <= WS_END, "ws map 3");

__device__ __forceinline__ int tid_l() { int t = threadIdx.x; asm volatile("" : "+v"(t)); return t; }
constexpr int LDS_BYTES = 131072 + 26624;
constexpr int NWAVES = 8;

namespace pg8 {
#define PG8_LAS __attribute__((address_space(3)))
typedef unsigned short bf16_t;
typedef short bf16x8 __attribute__((ext_vector_type(8)));
typedef float f32x4 __attribute__((ext_vector_type(4)));
typedef unsigned u32x4 __attribute__((ext_vector_type(4)));
typedef unsigned u32x2 __attribute__((ext_vector_type(2)));
constexpr int BM = 256, BK = 64, HALF = 128, HTB = HALF * BK * 2, STAGE_BYTES = 8 * HTB, NXCD = 8, WGM = 8;

__host__ __device__ __forceinline__ int lds_byte(int r, int c) { const int st = (r >> 4) * 2 + (c >> 5), rr = r & 15, cc = c & 31, ob = rr * 64 + cc * 2; return st * 1024 + (ob ^ (((ob >> 9) & 1) << 5)); }
__host__ __device__ __forceinline__ void stage_rc(int b, int& R, int& C) { const int st = b / 1024, sb = b % 1024, swz = sb ^ (((sb >> 9) & 1) << 5); R = (st >> 1) * 16 + swz / 64; C = (st & 1) * 32 + (swz % 64) / 2; }
__host__ __device__ __forceinline__ int perm32(int rho) { const int n = rho >> 4, i = rho & 15; return 8 * (i >> 2) + 4 * n + (i & 3); }

struct Unit { int pm, pn; };
struct Gemm { const bf16_t* A; const bf16_t* Bt; int M, N, K, lda, ldb, a_pn_cols; };

struct StaticOrder {
    int nM, nN, nwg, G, c;
    __host__ __device__ void init(int M, int N, int G_, int c_) { nM = M / BM; nN = N / BM; nwg = nM * nN; G = G_; c = c_; }
    __host__ __device__ bool next(int i, Unit& u) const {
        const long L = (long)i * G + c; if (L >= nwg) return false;
        int wgid = (int)L; { const int q = nwg / NXCD, r = nwg % NXCD, xcd = wgid % NXCD, off = wgid / NXCD; wgid = (xcd < r ? xcd * (q + 1) : r * (q + 1) + (xcd - r) * q) + off; }
        const int nig = WGM * nN, gid = wgid / nig, fm = gid * WGM, gsz = (nM - fm) < WGM ? (nM - fm) : WGM;
        u.pm = fm + ((wgid % nig) % gsz); u.pn = (wgid % nig) / gsz; return true;
    }
};

__device__ __forceinline__ unsigned cvt_pk_bf16(float lo, float hi) { unsigned r; asm volatile("v_cvt_pk_bf16_f32 %0, %1, %2" : "=v"(r) : "v"(lo), "v"(hi)); return r; }
typedef unsigned long long ss_t;
__device__ __forceinline__ float ss_rsqrt(const ss_t* ss, int row) { return __builtin_amdgcn_rsqf((float)ss[row] * (1.0f / 16777216.0f / DM) + EPS); }
__device__ __forceinline__ ss_t ss_fix(float sq) { return (ss_t)(sq * 16777216.0f + 0.5f); }
__device__ __forceinline__ void ss_rsqrt8(const ss_t* ss, int row0, float (&r)[2][4]) {
    ss_t v[2][4];
#pragma unroll
    for (int ai = 0; ai < 2; ++ai)
#pragma unroll
        for (int m = 0; m < 4; ++m) v[ai][m] = ss[row0 + ai * HALF + m * 16];
#pragma unroll
    for (int ai = 0; ai < 2; ++ai)
#pragma unroll
        for (int m = 0; m < 4; ++m) r[ai][m] = __builtin_amdgcn_rsqf((float)v[ai][m] * (1.0f / 16777216.0f / DM) + EPS);
}


struct EpiQKV {
    static constexpr bool PERM = true;
    bf16_t* Q; bf16_t* Kc; bf16_t* Vc; const ss_t* ss; const float* q_gain; const float* k_gain; const PG8_LAS float* rope; PG8_LAS float* part;
    __device__ __forceinline__ static size_t kv_off(int row, int bj) { return ((size_t)((row >> 12) * 2 + bj) * SEQ + (row & (SEQ - 1))) * HD; }
    __device__ __forceinline__ void operator()(const f32x4 (&acc)[2][2][4][2], const Unit& u, int wr, int wc, int fr, int fq) const {
        const int row0 = u.pm * BM + wr * 64 + fr, col0 = u.pn * BM + wc * 32 + 8 * fq;
        if (u.pn >= 5) {
#pragma unroll
            for (int ai = 0; ai < 2; ++ai)
#pragma unroll
                for (int m = 0; m < 4; ++m) { const int row = row0 + ai * HALF + m * 16; const float r = ss_rsqrt(ss, row);
#pragma unroll
                    for (int bj = 0; bj < 2; ++bj) { const f32x4 v0 = acc[ai][bj][m][0] * r, v1 = acc[ai][bj][m][1] * r;
                        u32x4 w; w.x = cvt_pk_bf16(v0[0], v0[1]); w.y = cvt_pk_bf16(v0[2], v0[3]); w.z = cvt_pk_bf16(v1[0], v1[1]); w.w = cvt_pk_bf16(v1[2], v1[3]);
                        *(u32x4*)(Vc + kv_off(row, bj) + wc * 32 + 8 * fq) = w; } }
            return;
        }
        float rr[2][4];
#pragma unroll
        for (int ai = 0; ai < 2; ++ai)
#pragma unroll
            for (int m = 0; m < 4; ++m) { const int rl = ai * HALF + wr * 64 + m * 16 + fr; const float r = ss_rsqrt(ss, u.pm * BM + rl); rr[ai][m] = r;
#pragma unroll
                for (int bj = 0; bj < 2; ++bj) { const f32x4 a = acc[ai][bj][m][0], b = acc[ai][bj][m][1];
                    float sq = ((a[0] * a[0] + a[1] * a[1]) + (a[2] * a[2] + a[3] * a[3])) + ((b[0] * b[0] + b[1] * b[1]) + (b[2] * b[2] + b[3] * b[3]));
                    sq += __shfl_xor(sq, 16); sq += __shfl_xor(sq, 32);
                    if (fq == 0) part[(rl * 2 + bj) * 4 + wc] = sq * r * r; } }
        asm volatile("s_waitcnt lgkmcnt(0)" ::: "memory"); __builtin_amdgcn_s_barrier(); asm volatile("" ::: "memory");
        const int half = wc >> 1, ib = (wc & 1) * 16 + 4 * fq; const float qsc = (u.pn == 4) ? 1.0f : 0.12752041570284543f;
        const float* gn = (u.pn == 4 ? k_gain : q_gain) + half * 64 + ib;
        const f32x4 g1 = *(const f32x4*)gn, g2 = *(const f32x4*)(gn + 32);
#pragma unroll
        for (int ai = 0; ai < 2; ++ai)
#pragma unroll
            for (int m = 0; m < 4; ++m) { const int rl = ai * HALF + wr * 64 + m * 16 + fr, row = u.pm * BM + rl, t = row & (SEQ - 1), pos = half ? (t & 63) : (t >> 6);
                const f32x4 cs01 = *(const PG8_LAS f32x4*)(rope + (pos * 32 + ib) * 2), cs23 = *(const PG8_LAS f32x4*)(rope + (pos * 32 + ib) * 2 + 4);
#pragma unroll
                for (int bj = 0; bj < 2; ++bj) { const f32x4 p4 = *(const PG8_LAS f32x4*)(part + (rl * 2 + bj) * 4);
                    bf16_t* dst = (u.pn == 4) ? Kc + kv_off(row, bj) + wc * 32 + 8 * fq : Q + (size_t)row * DM + col0 + bj * HALF;
                    const float rn = __builtin_amdgcn_rsqf(((p4[0] + p4[1]) + (p4[2] + p4[3])) * (1.0f / HD) + EPS) * rr[ai][m] * qsc;
                    const f32x4 a = acc[ai][bj][m][0] * rn, b = acc[ai][bj][m][1] * rn;
                    const float x10 = a[0] * g1[0], x20 = a[1] * g2[0], x11 = a[2] * g1[1], x21 = a[3] * g2[1], x12 = b[0] * g1[2], x22 = b[1] * g2[2], x13 = b[2] * g1[3], x23 = b[3] * g2[3];
                    u32x4 w;
                    w.x = cvt_pk_bf16(x10 * cs01[0] - x20 * cs01[1], x20 * cs01[0] + x10 * cs01[1]);
                    w.y = cvt_pk_bf16(x11 * cs01[2] - x21 * cs01[3], x21 * cs01[2] + x11 * cs01[3]);
                    w.z = cvt_pk_bf16(x12 * cs23[0] - x22 * cs23[1], x22 * cs23[0] + x12 * cs23[1]);
                    w.w = cvt_pk_bf16(x13 * cs23[2] - x23 * cs23[3], x23 * cs23[2] + x13 * cs23[3]);
                    *(u32x4*)dst = w; } }
    }
};
struct EpiSwiGLU {
    static constexpr bool PERM = true;
    bf16_t* H; const ss_t* ss;
    __device__ __forceinline__ void operator()(const f32x4 (&acc)[2][2][4][2], const Unit& u, int wr, int wc, int fr, int fq) const {
        const int row0 = u.pm * BM + wr * 64 + fr, col0 = u.pn * HALF + wc * 32 + 8 * fq;
        float rr[2][4]; ss_rsqrt8(ss, row0, rr);
#pragma unroll
        for (int ai = 0; ai < 2; ++ai)
#pragma unroll
            for (int m = 0; m < 4; ++m) { const int row = row0 + ai * HALF + m * 16; const float r = rr[ai][m];
                float hv[8];
#pragma unroll
                for (int n = 0; n < 2; ++n)
#pragma unroll
                    for (int j = 0; j < 4; ++j) { const float g = acc[ai][0][m][n][j] * r, uu = acc[ai][1][m][n][j] * r;
                        const float e = __builtin_amdgcn_exp2f(g * -1.4426950408889634f);
                        hv[n * 4 + j] = g * uu * __builtin_amdgcn_rcpf(1.0f + e); }
                u32x4 w; w.x = cvt_pk_bf16(hv[0], hv[1]); w.y = cvt_pk_bf16(hv[2], hv[3]); w.z = cvt_pk_bf16(hv[4], hv[5]); w.w = cvt_pk_bf16(hv[6], hv[7]);
                *(u32x4*)(H + (size_t)row * DFF + col0) = w; }
    }
};
struct EpiRes {
    static constexpr bool PERM = true;
    const float* xin_lo; const float* xin_hi; int split_pm; float* out; bf16_t* xb; ss_t* ss; const float* bias; const float* scale;
    template <bool F32, int NM>
    __device__ __forceinline__ void rows(const f32x4 (&acc)[2][2][4][2], const float* xin, int ai, int m0, int row0, int col0, int fq, const f32x4 (&bv)[2][2], const f32x4 (&sv)[2][2]) const {
        const size_t off0 = (size_t)(row0 + ai * HALF + m0 * 16) * DM + col0;
        f32x4 b[NM][2][2];
        if (F32) {
#pragma unroll
            for (int m = 0; m < NM; ++m)
#pragma unroll
                for (int bj = 0; bj < 2; ++bj)
#pragma unroll
                    for (int n = 0; n < 2; ++n) b[m][bj][n] = *(const f32x4*)(xin + off0 + (size_t)m * 16 * DM + bj * HALF + 4 * n);
        } else {
            u32x4 w[NM][2];
#pragma unroll
            for (int m = 0; m < NM; ++m)
#pragma unroll
                for (int bj = 0; bj < 2; ++bj) w[m][bj] = *(const u32x4*)(xb + off0 + (size_t)m * 16 * DM + bj * HALF);
#pragma unroll
            for (int m = 0; m < NM; ++m)
#pragma unroll
                for (int bj = 0; bj < 2; ++bj) {
                    b[m][bj][0] = (f32x4){__builtin_bit_cast(float, w[m][bj].x << 16), __builtin_bit_cast(float, w[m][bj].x & 0xffff0000u), __builtin_bit_cast(float, w[m][bj].y << 16), __builtin_bit_cast(float, w[m][bj].y & 0xffff0000u)};
                    b[m][bj][1] = (f32x4){__builtin_bit_cast(float, w[m][bj].z << 16), __builtin_bit_cast(float, w[m][bj].z & 0xffff0000u), __builtin_bit_cast(float, w[m][bj].w << 16), __builtin_bit_cast(float, w[m][bj].w & 0xffff0000u)}; }
        }
#pragma unroll
        for (int m = 0; m < NM; ++m) { const int row = row0 + ai * HALF + (m0 + m) * 16; const size_t off = off0 + (size_t)m * 16 * DM; float sq = 0.f;
#pragma unroll
            for (int bj = 0; bj < 2; ++bj) { f32x4 o[2];
#pragma unroll
                for (int n = 0; n < 2; ++n) { f32x4 v = acc[ai][bj][m0 + m][n];
                    if (bias) v = (v + bv[bj][n]) * sv[bj][n];
                    o[n] = b[m][bj][n] + v;
                    sq += (o[n][0] * o[n][0] + o[n][1] * o[n][1]) + (o[n][2] * o[n][2] + o[n][3] * o[n][3]); }
                if (out) { *(f32x4*)(out + off + bj * HALF) = o[0]; *(f32x4*)(out + off + bj * HALF + 4) = o[1]; }
                else { u32x4 w; w.x = cvt_pk_bf16(o[0][0], o[0][1]); w.y = cvt_pk_bf16(o[0][2], o[0][3]); w.z = cvt_pk_bf16(o[1][0], o[1][1]); w.w = cvt_pk_bf16(o[1][2], o[1][3]); *(u32x4*)(xb + off + bj * HALF) = w; } }
            if (ss) { sq += __shfl_xor(sq, 16); sq += __shfl_xor(sq, 32); if (fq == 0) atomicAdd(ss + row, ss_fix(sq)); } }
        asm volatile("" ::: "memory");
    }
    __device__ __forceinline__ void operator()(const f32x4 (&acc)[2][2][4][2], const Unit& u, int wr, int wc, int fr, int fq) const {
        const int col0 = u.pn * BM + wc * 32 + 8 * fq, row0 = u.pm * BM + wr * 64 + fr;
        const float* xin = (u.pm < split_pm) ? xin_lo : xin_hi;
        f32x4 bv[2][2], sv[2][2];
#pragma unroll
        for (int bj = 0; bj < 2; ++bj)
#pragma unroll
            for (int n = 0; n < 2; ++n) { bv[bj][n] = bias ? *(const f32x4*)(bias + col0 + bj * HALF + 4 * n) : (f32x4){0.f, 0.f, 0.f, 0.f}; sv[bj][n] = bias ? *(const f32x4*)(scale + col0 + bj * HALF + 4 * n) : (f32x4){1.f, 1.f, 1.f, 1.f}; }
        if (xin) {
#pragma unroll
            for (int ai = 0; ai < 2; ++ai) { rows<true, 2>(acc, xin, ai, 0, row0, col0, fq, bv, sv); rows<true, 2>(acc, xin, ai, 2, row0, col0, fq, bv, sv); }
        } else if (bias) {
#pragma unroll
            for (int ai = 0; ai < 2; ++ai) rows<false, 4>(acc, xin, ai, 0, row0, col0, fq, bv, sv);
        } else {
            u32x4 w[2][4][2];
#pragma unroll
            for (int ai = 0; ai < 2; ++ai)
#pragma unroll
                for (int m = 0; m < 4; ++m)
#pragma unroll
                    for (int bj = 0; bj < 2; ++bj) w[ai][m][bj] = *(const u32x4*)(xb + (size_t)(row0 + ai * HALF + m * 16) * DM + col0 + bj * HALF);
#pragma unroll
            for (int ai = 0; ai < 2; ++ai)
#pragma unroll
                for (int m = 0; m < 4; ++m) { const int row = row0 + ai * HALF + m * 16; const size_t off = (size_t)row * DM + col0; float sq = 0.f;
#pragma unroll
                    for (int bj = 0; bj < 2; ++bj) { const u32x4 ww = w[ai][m][bj]; f32x4 o[2];
                        const f32x4 b0 = (f32x4){__builtin_bit_cast(float, ww.x << 16), __builtin_bit_cast(float, ww.x & 0xffff0000u), __builtin_bit_cast(float, ww.y << 16), __builtin_bit_cast(float, ww.y & 0xffff0000u)};
                        const f32x4 b1 = (f32x4){__builtin_bit_cast(float, ww.z << 16), __builtin_bit_cast(float, ww.z & 0xffff0000u), __builtin_bit_cast(float, ww.w << 16), __builtin_bit_cast(float, ww.w & 0xffff0000u)};
#pragma unroll
                        for (int n = 0; n < 2; ++n) { o[n] = (n ? b1 : b0) + acc[ai][bj][m][n];
                            sq += (o[n][0] * o[n][0] + o[n][1] * o[n][1]) + (o[n][2] * o[n][2] + o[n][3] * o[n][3]); }
                        if (out) { *(f32x4*)(out + off + bj * HALF) = o[0]; *(f32x4*)(out + off + bj * HALF + 4) = o[1]; }
                        else { u32x4 r; r.x = cvt_pk_bf16(o[0][0], o[0][1]); r.y = cvt_pk_bf16(o[0][2], o[0][3]); r.z = cvt_pk_bf16(o[1][0], o[1][1]); r.w = cvt_pk_bf16(o[1][2], o[1][3]); *(u32x4*)(xb + off + bj * HALF) = r; } }
                    if (ss) { sq += __shfl_xor(sq, 16); sq += __shfl_xor(sq, 32); if (fq == 0) atomicAdd(ss + row, ss_fix(sq)); } }
        }
    }
};

template <class Epi, class Sched>
__device__ __forceinline__ void gemm_phase(PG8_LAS unsigned char* lds, const Gemm g, const Sched& S, const Epi& E) {
    const int tid = tid_l(), wid = __builtin_amdgcn_readfirstlane(tid >> 6), lane = tid & 63, wr = wid >> 2, wc = wid & 3, fr = lane & 15, fq = lane >> 4;
    const int K = g.K, nt = K / BK;
    unsigned voffA[2], voffB[2];
#pragma unroll
    for (int i = 0; i < 2; ++i) { int R, C; stage_rc(tid * 16 + i * 8192, R, C); const int Rb = Epi::PERM ? ((R & ~31) + perm32(R & 31)) : R;
        voffA[i] = (unsigned)(R * g.lda + C) * 2u; voffB[i] = (unsigned)(Rb * g.ldb + C) * 2u; }
    const size_t kstep = (size_t)(BK * 2);
    const size_t hstepA = (size_t)HALF * g.lda * 2, hstepB = (size_t)HALF * g.ldb * 2;
    const size_t tstepA = 2 * hstepA, tstepB = 2 * hstepB, pnstepA = (size_t)g.a_pn_cols * 2;
    const unsigned ldsw = (unsigned)wid * 1024u;
    const int aoff = lds_byte(wr * 64 + fr, fq * 8), boff = lds_byte(wc * 32 + fr, fq * 8);
#define PG8_SA(b, h) (((b) * 2 + (h)) * HTB)
#define PG8_SB(b, h) ((4 + (b) * 2 + (h)) * HTB)
#define PG8_STAGE(bufoff, gbase, voff) do { _Pragma("unroll") for (int _i = 0; _i < 2; ++_i) \
        __builtin_amdgcn_global_load_lds((const unsigned*)((const char*)(gbase) + (voff)[_i]), (PG8_LAS unsigned*)(lds + (bufoff) + ldsw + _i * 8192), 16, 0, 0); } while (0)
#define PG8_LDA(dst, b, h) do { _Pragma("unroll") for (int m = 0; m < 4; ++m) _Pragma("unroll") for (int k = 0; k < 2; ++k) dst[m][k] = *(const PG8_LAS bf16x8*)(lds + PG8_SA(b, h) + aoff + m * 2048 + k * 1024); } while (0)
#define PG8_LDB(dst, b, h) do { _Pragma("unroll") for (int n = 0; n < 2; ++n) _Pragma("unroll") for (int k = 0; k < 2; ++k) dst[n][k] = *(const PG8_LAS bf16x8*)(lds + PG8_SB(b, h) + boff + n * 2048 + k * 1024); } while (0)
#define PG8_MMA(ai, bj, At, Bt) do { __builtin_amdgcn_s_setprio(1); _Pragma("unroll") for (int m = 0; m < 4; ++m) _Pragma("unroll") for (int n = 0; n < 2; ++n) _Pragma("unroll") for (int k = 0; k < 2; ++k) \
        acc[ai][bj][m][n] = __builtin_amdgcn_mfma_f32_16x16x32_bf16(Bt[n][k], At[m][k], acc[ai][bj][m][n], 0, 0, 0); __builtin_amdgcn_s_setprio(0); } while (0)
#define PG8_WAIT_V(n) asm volatile("s_waitcnt vmcnt(" #n ")" ::: "memory")
#define PG8_WAIT_L(n) asm volatile("s_waitcnt lgkmcnt(" #n ")" ::: "memory")
#define PG8_BAR __builtin_amdgcn_s_barrier()
#define PG8_SCHED __builtin_amdgcn_sched_barrier(0)
    Unit cur, nxt; int ui = 0;
    if (!S.next(0, cur)) return;
    f32x4 acc[2][2][4][2];
#pragma unroll
    for (int a = 0; a < 2; ++a)
#pragma unroll
        for (int b = 0; b < 2; ++b)
#pragma unroll
            for (int m = 0; m < 4; ++m)
#pragma unroll
                for (int n = 0; n < 2; ++n) acc[a][b][m][n] = (f32x4){0.f, 0.f, 0.f, 0.f};
    bf16x8 At[4][2], B0[2][2], B1[2][2];
    const char* cA = (const char*)g.A + (size_t)cur.pm * tstepA + (size_t)cur.pn * pnstepA; const char* cB = (const char*)g.Bt + (size_t)cur.pn * tstepB;
    PG8_STAGE(PG8_SB(0, 0), cB, voffB); PG8_STAGE(PG8_SB(0, 1), cB + hstepB, voffB); PG8_STAGE(PG8_SA(0, 0), cA, voffA); PG8_STAGE(PG8_SA(0, 1), cA + hstepA, voffA);
    if (wr == 1) PG8_BAR;
    PG8_WAIT_V(2); PG8_BAR;
    PG8_STAGE(PG8_SB(1, 0), cB + kstep, voffB); PG8_STAGE(PG8_SA(1, 0), cA + kstep, voffA); PG8_STAGE(PG8_SB(1, 1), cB + hstepB + kstep, voffB);
    PG8_WAIT_V(6); PG8_BAR;
    for (;;) {
        const bool has_next = S.next(ui + 1, nxt);
        const char* nA = has_next ? (const char*)g.A + (size_t)nxt.pm * tstepA + (size_t)nxt.pn * pnstepA : cA; const char* nB = has_next ? (const char*)g.Bt + (size_t)nxt.pn * tstepB : cB;
        for (int t = 0; t < nt; t += 2) {
            const bool last = (t == nt - 2);
            const char* a1 = cA + (size_t)(t + 1) * kstep;
            const char* a2 = last ? nA : cA + (size_t)(t + 2) * kstep; const char* b2 = last ? nB : cB + (size_t)(t + 2) * kstep;
            const char* a3 = a2 + kstep; const char* b3 = b2 + kstep;
            PG8_LDB(B0, 0, 0); PG8_LDB(B1, 0, 1); PG8_SCHED; PG8_LDA(At, 0, 0); PG8_STAGE(PG8_SA(1, 1), a1 + hstepA, voffA);
            PG8_WAIT_V(8); PG8_WAIT_L(0); PG8_BAR; PG8_MMA(0, 0, At, B0); PG8_MMA(0, 1, At, B1); PG8_BAR; PG8_SCHED;
            PG8_LDA(At, 0, 1); PG8_STAGE(PG8_SB(0, 0), b2, voffB); PG8_STAGE(PG8_SB(0, 1), b2 + hstepB, voffB); PG8_STAGE(PG8_SA(0, 0), a2, voffA);
            PG8_WAIT_V(8); PG8_WAIT_L(0); PG8_BAR; PG8_MMA(1, 0, At, B0); PG8_MMA(1, 1, At, B1); PG8_BAR; PG8_SCHED;
            PG8_LDB(B0, 1, 0); PG8_LDB(B1, 1, 1); PG8_SCHED; PG8_LDA(At, 1, 0); PG8_STAGE(PG8_SA(0, 1), a2 + hstepA, voffA);
            PG8_WAIT_V(8); PG8_WAIT_L(0); PG8_BAR; PG8_MMA(0, 0, At, B0); PG8_MMA(0, 1, At, B1); PG8_BAR; PG8_SCHED;
            PG8_LDA(At, 1, 1); PG8_STAGE(PG8_SB(1, 0), b3, voffB); PG8_STAGE(PG8_SB(1, 1), b3 + hstepB, voffB); PG8_STAGE(PG8_SA(1, 0), a3, voffA);
            PG8_WAIT_V(8); PG8_WAIT_L(0); PG8_BAR; PG8_MMA(1, 0, At, B0); PG8_MMA(1, 1, At, B1); PG8_BAR; PG8_SCHED;
        }
        if (wr == 0) PG8_BAR;
        E(acc, cur, wr, wc, fr, fq);
        if (!has_next) break;
#pragma unroll
        for (int a = 0; a < 2; ++a)
#pragma unroll
            for (int b = 0; b < 2; ++b)
#pragma unroll
                for (int m = 0; m < 4; ++m)
#pragma unroll
                    for (int n = 0; n < 2; ++n) acc[a][b][m][n] = (f32x4){0.f, 0.f, 0.f, 0.f};
        cur = nxt; cA = nA; cB = nB; ++ui;
        if (wr == 1) PG8_BAR;
    }
    PG8_WAIT_V(0);
    PG8_BAR;
#undef PG8_SA
#undef PG8_SB
#undef PG8_STAGE
#undef PG8_LDA
#undef PG8_LDB
#undef PG8_MMA
#undef PG8_WAIT_V
#undef PG8_WAIT_L
#undef PG8_BAR
#undef PG8_SCHED
}
}

namespace attn {
using bf16 = __hip_bfloat16;
constexpr int D = 128, NW = 8, QBLK = 32, KVBLK = 64;
constexpr float SCALE = 0.088388347648318440f;
constexpr float QSCALE = SCALE * 1.4426950408889634f;
constexpr float THR = 8.f;
constexpr int SDEPTH = 2;
constexpr int LDQ = DM, LDK = HD, LDO = DM;
constexpr size_t SHM_V = KVBLK * D * 2, SHM_K = KVBLK * D * 2, SHM_ATTN = 2 * SHM_V + 2 * SHM_K + NW * 64 * 4;
using bf16x8 = __attribute__((ext_vector_type(8))) short;
using s16x4  = __attribute__((ext_vector_type(4))) short;
using f32x16 = __attribute__((ext_vector_type(16))) float;
using u32x4  = __attribute__((ext_vector_type(4))) unsigned;
#define KSWZ(row, colB) ((row) * 256 + ((colB) ^ (((row) & 7) << 4)))
#define SBAR() __builtin_amdgcn_sched_barrier(0)
__device__ __forceinline__ int crow(int r, int hi) { return (r & 3) + 8 * (r >> 2) + 4 * hi; }
__device__ __forceinline__ unsigned cvtpk(float lo, float hi) { unsigned r; asm volatile("v_cvt_pk_bf16_f32 %0, %1, %2" : "=v"(r) : "v"(lo), "v"(hi)); return r; }
__device__ __forceinline__ bf16x8 ld8(const bf16* p) { return *reinterpret_cast<const bf16x8*>(p); }

__device__ __forceinline__ void partialSM(f32x16& p0, f32x16& p1, float& m_reg, float& mn, float& alpha) {
  float pmax = p0[0]; for (int r = 1; r < 16; ++r) pmax = fmaxf(pmax, p0[r]); for (int r = 0; r < 16; ++r) pmax = fmaxf(pmax, p1[r]);
  { auto rr = __builtin_amdgcn_permlane32_swap(__float_as_uint(pmax), __float_as_uint(pmax), false, false);
    pmax = fmaxf(__uint_as_float(rr[0]), __uint_as_float(rr[1])); }
  if (__builtin_expect(__all(pmax - m_reg <= THR * 1.4426950408889634f), 1)) { mn = m_reg; alpha = 1.f; }
  else { mn = fmaxf(m_reg, pmax); alpha = __builtin_amdgcn_exp2f(m_reg - mn); m_reg = mn; }
  for (int r = 0; r < 16; ++r) p0[r] = p0[r] - mn; for (int r = 0; r < 16; ++r) p1[r] = p1[r] - mn;
  for (int r = 0; r < 16; ++r) p0[r] = __builtin_amdgcn_exp2f(p0[r]);
}
__device__ __forceinline__ void finishSM(f32x16& p0, f32x16& p1, float alpha, float& l_reg, bf16x8& pa0, bf16x8& pa1, bf16x8& pa2, bf16x8& pa3) {
  for (int r = 0; r < 16; ++r) p1[r] = __builtin_amdgcn_exp2f(p1[r]);
  float ps = 0; for (int r = 0; r < 16; ++r) ps += p0[r]; for (int r = 0; r < 16; ++r) ps += p1[r];
  { auto rr = __builtin_amdgcn_permlane32_swap(__float_as_uint(ps), __float_as_uint(ps), false, false);
    ps = __uint_as_float(rr[0]) + __uint_as_float(rr[1]); }
  l_reg = l_reg * alpha + ps;
#define PK4(P, BASE, OUT) do { unsigned a0 = cvtpk(P[BASE + 0], P[BASE + 1]), a1 = cvtpk(P[BASE + 2], P[BASE + 3]);   \
    unsigned b0 = cvtpk(P[BASE + 4], P[BASE + 5]), b1 = cvtpk(P[BASE + 6], P[BASE + 7]);                              \
    auto r0 = __builtin_amdgcn_permlane32_swap(a0, b0, false, false); auto r1 = __builtin_amdgcn_permlane32_swap(a1, b1, false, false); \
    u32x4 w = {r0[0], r1[0], r0[1], r1[1]}; OUT = *reinterpret_cast<bf16x8*>(&w); } while (0)
  PK4(p0, 0, pa0); PK4(p0, 8, pa1); PK4(p1, 0, pa2); PK4(p1, 8, pa3);
#undef PK4
}
__device__ __forceinline__ void partialSM_b(f32x16& p0, f32x16& p1) {
  for (int r = 0; r < 16; ++r) p0[r] = __builtin_amdgcn_exp2f(p0[r]);
}
__device__ __forceinline__ void qkt(f32x16& p0, f32x16& p1, const bf16* Ks, const bf16x8* qr, int r32, int hi) {
  p0 = f32x16{}; p1 = f32x16{};
  for (int d0 = 0; d0 < 8; ++d0) { int cb = (d0 * 16 + hi * 8) * 2;
    bf16x8 b0 = *reinterpret_cast<const bf16x8*>((const char*)Ks + KSWZ(r32, cb));
    bf16x8 b1 = *reinterpret_cast<const bf16x8*>((const char*)Ks + KSWZ(32 + r32, cb));
    p0 = __builtin_amdgcn_mfma_f32_32x32x16_bf16(b0, qr[d0], p0, 0, 0, 0);
    p1 = __builtin_amdgcn_mfma_f32_32x32x16_bf16(b1, qr[d0], p1, 0, 0, 0); }
}
__device__ __forceinline__ int v_st(int k, int c) { const int kk = (k & ~0xC) | ((k & 4) << 1) | ((k & 8) >> 1); return ((kk >> 3) * 4 + (c >> 5)) * 512 + ((kk & 7) * 32 + (c & 31)) * 2; }
__device__ __forceinline__ int v_rd_base(int lane) { return ((lane & 3) << 3) | (((lane >> 2) & 3) << 6) | (((lane >> 4) & 1) << 5) | (((lane >> 5) & 1) << 8); }
constexpr int v_rd_off(int d0, int ks, int half) { return d0 * 512 + ks * 4096 + half * 2048; }
template <int OFF> __device__ __forceinline__ s16x4 tr_read(int vb) {
  s16x4 r; asm volatile("ds_read_b64_tr_b16 %0, %1 offset:%2" : "=&v"(r) : "v"(vb), "i"(OFF) : "memory"); return r;
}
template <int D0> __device__ __forceinline__ void pv_one(f32x16& od, int vb, bf16x8 pa0, bf16x8 pa1, bf16x8 pa2, bf16x8 pa3) {
  const s16x4 l0 = tr_read<v_rd_off(D0, 0, 0)>(vb), h0 = tr_read<v_rd_off(D0, 0, 1)>(vb), l1 = tr_read<v_rd_off(D0, 1, 0)>(vb), h1 = tr_read<v_rd_off(D0, 1, 1)>(vb);
  const s16x4 l2 = tr_read<v_rd_off(D0, 2, 0)>(vb), h2 = tr_read<v_rd_off(D0, 2, 1)>(vb), l3 = tr_read<v_rd_off(D0, 3, 0)>(vb), h3 = tr_read<v_rd_off(D0, 3, 1)>(vb);
  asm volatile("s_waitcnt lgkmcnt(0)" ::: "memory"); SBAR();
#define PK(L, H) (bf16x8){L[0], L[1], L[2], L[3], H[0], H[1], H[2], H[3]}
  od = __builtin_amdgcn_mfma_f32_32x32x16_bf16(pa0, PK(l0, h0), od, 0, 0, 0);
  od = __builtin_amdgcn_mfma_f32_32x32x16_bf16(pa1, PK(l1, h1), od, 0, 0, 0);
  od = __builtin_amdgcn_mfma_f32_32x32x16_bf16(pa2, PK(l2, h2), od, 0, 0, 0);
  od = __builtin_amdgcn_mfma_f32_32x32x16_bf16(pa3, PK(l3, h3), od, 0, 0, 0);
#undef PK
}
__device__ __forceinline__ void pv_d0(f32x16* o, int vb, bf16x8 pa0, bf16x8 pa1, bf16x8 pa2, bf16x8 pa3) {
  pv_one<0>(o[0], vb, pa0, pa1, pa2, pa3); pv_one<1>(o[1], vb, pa0, pa1, pa2, pa3); pv_one<2>(o[2], vb, pa0, pa1, pa2, pa3); pv_one<3>(o[3], vb, pa0, pa1, pa2, pa3);
}

template <bool BOUNDED>
__device__ __forceinline__ void attn_dense_body(const bf16* __restrict__ Qb, const bf16* __restrict__ Kh, const bf16* __restrict__ Vh,
                                                unsigned short* __restrict__ Ob, int seq, char* lds) {
  const int tid = tid_l(), wid = tid >> 6, lane = tid & 63, r32 = lane & 31, hi = lane >> 5;
  bf16* V_lds = (bf16*)lds; bf16* K_lds = (bf16*)(lds + 2 * SHM_V);
  float* ws = (float*)(lds + 2 * SHM_V + 2 * SHM_K) + wid * 64; float* li_l = ws; float* al_l = ws + 32;
  float m_reg = -1e30f, l_reg = 0; f32x16 o[4] = {}; bf16x8 qr[8];
  const bf16* Qw = Qb + (long)(wid * QBLK + r32) * LDQ + hi * 8;
#pragma unroll
  for (int d0 = 0; d0 < 8; ++d0) qr[d0] = ld8(Qw + d0 * 16);
  const int sr = tid >> 4, sc = (tid & 15) * 8, vst0 = v_st(sr, sc), vst1 = v_st(32 + sr, sc);
  const int vb0 = (int)(uintptr_t)V_lds + v_rd_base(lane);
  struct { bf16x8 vs0, vs1, ks0, ks1; } sr_[SDEPTH];
  const unsigned vo0 = (unsigned)(sr * LDK + sc) * 2u, vo1 = vo0 + 32u * LDK * 2u;
#define SLOAD(i, k0) do { const char* kb_ = (const char*)Kh + (size_t)(k0) * (LDK * 2); const char* vb_ = (const char*)Vh + (size_t)(k0) * (LDK * 2); \
    sr_[i].vs0 = *(const bf16x8*)(vb_ + vo0); sr_[i].vs1 = *(const bf16x8*)(vb_ + vo1); sr_[i].ks0 = *(const bf16x8*)(kb_ + vo0); sr_[i].ks1 = *(const bf16x8*)(kb_ + vo1); } while (0)
#define SWRITE(b, i) do { *(bf16x8*)((char*)V_lds + (b) * SHM_V + vst0) = sr_[i].vs0;          \
    *(bf16x8*)((char*)V_lds + (b) * SHM_V + vst1) = sr_[i].vs1; int kc = sc * 2;               \
    *(bf16x8*)((char*)K_lds + (b) * SHM_K + KSWZ(sr, kc)) = sr_[i].ks0;                       \
    *(bf16x8*)((char*)K_lds + (b) * SHM_K + KSWZ(32 + sr, kc)) = sr_[i].ks1; } while (0)
#define SWAIT() do { asm volatile("s_waitcnt vmcnt(4)" ::: "memory"); } while (0)
#define RESC(a) do { if (__any((a) < 1.f)) { if (hi == 0) al_l[r32] = (a); asm volatile("s_waitcnt lgkmcnt(0)" ::: "memory"); \
    for (int d = 0; d < 4; ++d) for (int r = 0; r < 16; ++r) o[d][r] *= al_l[crow(r, hi)]; } } while (0)
#define PSM(P0, P1, MN, AL) do { if constexpr (BOUNDED) { partialSM_b(P0, P1); AL = 1.f; } else partialSM(P0, P1, m_reg, MN, AL); } while (0)
  f32x16 pA0, pA1, pB0, pB1; float mnA = 0.f, mnB = 0.f, alA = 1.f, alB = 1.f; bf16x8 pa0, pa1, pa2, pa3; int NT = seq / KVBLK; asm volatile("" : "+s"(NT));
  constexpr int SE = 0, SO = SDEPTH - 1;
  SLOAD(SE, 0); SLOAD(SO, KVBLK);
  SWAIT(); SWRITE(0, SE); __syncthreads();
  SLOAD(SE, 2 * KVBLK);
  qkt(pA0, pA1, K_lds, qr, r32, hi); PSM(pA0, pA1, mnA, alA);
  SWAIT(); SWRITE(1, SO); __syncthreads();
  for (int j = 1; j + 1 < NT; j += 2) {
    SBAR(); qkt(pB0, pB1, (bf16*)((char*)K_lds + SHM_K), qr, r32, hi);
    finishSM(pA0, pA1, alA, l_reg, pa0, pa1, pa2, pa3); SBAR();
    SLOAD(SO, (j + SDEPTH) * KVBLK); SBAR();
    pv_d0(o, vb0, pa0, pa1, pa2, pa3); PSM(pB0, pB1, mnB, alB);
    __syncthreads(); SWAIT(); SWRITE(0, SE);
    if constexpr (!BOUNDED) RESC(alB); __syncthreads();
    SBAR(); qkt(pA0, pA1, K_lds, qr, r32, hi);
    finishSM(pB0, pB1, alB, l_reg, pa0, pa1, pa2, pa3); SBAR();
    SLOAD(SE, ((j + 3 < NT) ? (j + 1 + SDEPTH) : (NT - 1)) * KVBLK); SBAR();
    pv_d0(o, vb0 + (int)SHM_V, pa0, pa1, pa2, pa3); PSM(pA0, pA1, mnA, alA);
    __syncthreads(); SWAIT(); SWRITE(1, SO);
    if constexpr (!BOUNDED) RESC(alA); __syncthreads();
  }
  SBAR(); qkt(pB0, pB1, (bf16*)((char*)K_lds + SHM_K), qr, r32, hi);
  finishSM(pA0, pA1, alA, l_reg, pa0, pa1, pa2, pa3); SBAR();
  pv_d0(o, vb0, pa0, pa1, pa2, pa3); PSM(pB0, pB1, mnB, alB);
  __syncthreads(); if constexpr (!BOUNDED) RESC(alB);
  finishSM(pB0, pB1, alB, l_reg, pa0, pa1, pa2, pa3); SBAR();
  pv_d0(o, vb0 + (int)SHM_V, pa0, pa1, pa2, pa3);
  if (hi == 0) li_l[r32] = l_reg; asm volatile("s_waitcnt lgkmcnt(0)" ::: "memory");
  float rli[16];
#pragma unroll
  for (int r = 0; r < 16; ++r) rli[r] = __builtin_amdgcn_rcpf(li_l[crow(r, hi)]);
  unsigned short* Ow = Ob + (long)(wid * QBLK) * LDO;
  const int odd = lane & 1;
#pragma unroll
  for (int r = 0; r < 16; r += 2) { const int orow = crow(r + odd, hi);
#pragma unroll
    for (int d0 = 0; d0 < 4; ++d0) { const float a = o[d0][r] * rli[r], b = o[d0][r + 1] * rli[r + 1];
      const float send = odd ? a : b; const float recv = __shfl_xor(send, 1);
      const unsigned w = odd ? cvtpk(recv, b) : cvtpk(a, recv);
      *(unsigned*)(Ow + (long)orow * LDO + d0 * 32 + (r32 & ~1)) = w; } }
  __syncthreads();
#undef SLOAD
#undef SWRITE
#undef SWAIT
#undef RESC
#undef PSM
}
#undef KSWZ
#undef SBAR
}

#define LAS __attribute__((address_space(3)))
typedef unsigned short bf16;
typedef unsigned v4u __attribute__((ext_vector_type(4)));
typedef unsigned v2u __attribute__((ext_vector_type(2)));
typedef float f32x4 __attribute__((ext_vector_type(4)));
#define LDS_WAIT() asm volatile("s_waitcnt lgkmcnt(0)" ::: "memory")
__device__ __forceinline__ unsigned f2bf(float f) { unsigned u = __builtin_bit_cast(unsigned, f); return (u + 0x7fffu + ((u >> 16) & 1u)) >> 16; }
__device__ __forceinline__ unsigned pk2(float lo, float hi) { return f2bf(lo) | (f2bf(hi) << 16); }
__device__ __forceinline__ float bf_lo(unsigned w) { return __builtin_bit_cast(float, w << 16); }
__device__ __forceinline__ float bf_hi(unsigned w) { return __builtin_bit_cast(float, w & 0xffff0000u); }
__device__ __forceinline__ float wave_sum(float v) {
#pragma unroll
    for (int o = 1; o < 64; o <<= 1) v += __shfl_xor(v, o);
    return v;
}

struct Args { const float* in[13]; float* out; unsigned char* ws; int ph_lo, ph_hi; };
typedef const Args __attribute__((address_space(4)))* KArgs;

__device__ __forceinline__ int map_src_col(int mode, int n) {
    if (mode == 1) { const int pn = n >> 8, w = n & 255; return w < 128 ? pn * 128 + w : DFF + pn * 128 + (w - 128); }
    if (mode == 2) { if (n >= 1280) return n; const int h = n >> 7, d = n & 127, half = d >> 6, dd = d & 63; return h * 128 + half * 64 + (dd >> 1) + 32 * (dd & 1); }
    return n;
}
__device__ __forceinline__ void transpose_item(const float* W, int K, int N, bf16* WT, const float* gain, int mode, LAS float* scr, int item, int lane) {
    const int nblk = N / 32, kb = item / nblk, nb = item % nblk, k0 = 64 * kb, n0 = 32 * nb;
    const int srcc = map_src_col(mode, n0 + (lane & 31));
    float wv[32];
#pragma unroll
    for (int i = 0; i < 32; ++i) wv[i] = W[(size_t)(k0 + 2 * i + (lane >> 5)) * N + srcc];
#pragma unroll
    for (int i = 0; i < 32; ++i) { const int kk = 2 * i + (lane >> 5); float v = wv[i]; if (gain) v *= gain[k0 + kk]; scr[kk * 33 + (lane & 31)] = v; }
    LDS_WAIT(); asm volatile("" ::: "memory");
    const int c = lane & 7;
#pragma unroll
    for (int j = 0; j < 4; ++j) { const int n = (lane >> 3) + 8 * j; const LAS float* s = scr + (8 * c) * 33 + n;
        v4u o; o.x = pk2(s[0 * 33], s[1 * 33]); o.y = pk2(s[2 * 33], s[3 * 33]); o.z = pk2(s[4 * 33], s[5 * 33]); o.w = pk2(s[6 * 33], s[7 * 33]);
        *(v4u*)(WT + (size_t)(n0 + n) * K + k0 + 8 * c) = o; }
    LDS_WAIT(); asm volatile("" ::: "memory");
}

__device__ __forceinline__ void p0_prologue(KArgs a, LAS unsigned char* lds, int gw, int NGW, int wave, int lane) {
    unsigned char* ws = a->ws;
    LAS float* scr = (LAS float*)(lds + wave * 16384);
    const float* norm_mix = a->in[2]; const float* norm_ffn = a->in[3]; const float* pool_w = a->in[4];
    const float* w_qkv = a->in[7]; const float* w_o = a->in[10]; const float* w_gu = a->in[11]; const float* w_d = a->in[12];
    const float* x0 = a->in[0]; const float* x1 = a->in[1];
    constexpr int I_GU = (DM / 64) * (NGU / 32), I_D = (DFF / 64) * (DM / 32), I_QKV = (DM / 64) * (NQKV / 32), I_O = (DM / 64) * (DM / 32), I_P = (256 / 64) * (256 / 32);
    constexpr int NITEMS = 4 * I_GU + 4 * I_D + 2 * I_QKV + 2 * I_O + 8 * I_P;
    for (int it = gw; it < NITEMS; it += NGW) {
        int r = it;
        if (r < 4 * I_GU) { const int l = r / I_GU; r -= l * I_GU; transpose_item(w_gu + (size_t)l * DM * NGU, DM, NGU, (bf16*)(ws + WS_WGU) + (size_t)l * NGU * DM, norm_ffn + l * DM, 1, scr, r, lane); continue; } r -= 4 * I_GU;
        if (r < 4 * I_D) { const int l = r / I_D; r -= l * I_D; transpose_item(w_d + (size_t)l * DFF * DM, DFF, DM, (bf16*)(ws + WS_WD) + (size_t)l * DM * DFF, nullptr, 0, scr, r, lane); continue; } r -= 4 * I_D;
        if (r < 2 * I_QKV) { const int l = r / I_QKV; r -= l * I_QKV; transpose_item(w_qkv + (size_t)l * DM * NQKV, DM, NQKV, (bf16*)(ws + WS_WQKV) + (size_t)l * NQKV * DM, norm_mix + (2 * l + 1) * DM, 2, scr, r, lane); continue; } r -= 2 * I_QKV;
        if (r < 2 * I_O) { const int l = r / I_O; r -= l * I_O; transpose_item(w_o + (size_t)l * DM * DM, DM, DM, (bf16*)(ws + WS_WO) + (size_t)l * DM * DM, nullptr, 0, scr, r, lane); continue; } r -= 2 * I_O;
        { const int l = r / I_P; r -= l * I_P; transpose_item(pool_w + (size_t)l * 256 * 256, 256, 256, (bf16*)(ws + WS_WP) + (size_t)l * 256 * 256, nullptr, 0, scr, r, lane); }
    }
    for (int e = gw * 64 + lane; e < 64 * 32; e += NGW * 64) { const int pos = e >> 5, i = e & 31;
        const float inv = exp2f(-(float)(2 * i) * (1.0f / 64.0f) * 13.287712379549449f);
        const float ang = (float)pos * inv; float rev = ang * 0.15915494309189535f; rev -= floorf(rev);
        float2 cs; cs.x = __builtin_amdgcn_cosf(rev); cs.y = __builtin_amdgcn_sinf(rev);
        ((float2*)(ws + WS_ROPE))[e] = cs; }
    if (gw < 2) { const float* qg = a->in[8] + gw * HD; const float* kg = a->in[9] + gw * HD;
        float mq = fmaxf(fabsf(qg[lane]), fabsf(qg[lane + 64])), mk = fmaxf(fabsf(kg[lane]), fabsf(kg[lane + 64]));
#pragma unroll
        for (int o = 1; o < 64; o <<= 1) { mq = fmaxf(mq, __shfl_xor(mq, o)); mk = fmaxf(mk, __shfl_xor(mk, o)); }
        if (lane == 0) ((float*)(ws + WS_BOUND))[gw] = 11.313708498984761f * mq * mk * 1.02f; }
    { pg8::ss_t* ss = (pg8::ss_t*)(ws + WS_SS); for (size_t e = (size_t)gw * 64 + lane + M_TOT; e < (size_t)8 * M_TOT; e += (size_t)NGW * 64) ss[e] = 0ull; }
    { pg8::ss_t* ss = (pg8::ss_t*)(ws + WS_SS);
      for (int m = gw; m < M_TOT; m += 2 * NGW) { const int m2 = m + NGW;
          const bool has2 = m2 < M_TOT; const int mb = has2 ? m2 : m;
          const float* xa = (m < 4 * SEQ) ? x0 + (size_t)m * DM : x1 + (size_t)(m - 4 * SEQ) * DM; const float* xb_ = (mb < 4 * SEQ) ? x0 + (size_t)mb * DM : x1 + (size_t)(mb - 4 * SEQ) * DM;
          const f32x4* a4 = (const f32x4*)xa + lane; const f32x4* b4 = (const f32x4*)xb_ + lane; f32x4 va[4], vb[4];
#pragma unroll
          for (int j = 0; j < 4; ++j) { va[j] = a4[64 * j]; vb[j] = b4[64 * j]; }
          float sa = 0.f, sb = 0.f;
#pragma unroll
          for (int j = 0; j < 4; ++j) { sa += (va[j].x * va[j].x + va[j].y * va[j].y) + (va[j].z * va[j].z + va[j].w * va[j].w); sb += (vb[j].x * vb[j].x + vb[j].y * vb[j].y) + (vb[j].z * vb[j].z + vb[j].w * vb[j].w); }
          sa = wave_sum(sa); sb = wave_sum(sb); if (lane == 0) { ss[m] = pg8::ss_fix(sa); if (has2) ss[m2] = pg8::ss_fix(sb); } } }
}

template <bool F32IN, int GI>
__device__ __forceinline__ void pool_item(const float* xf, const bf16* xb, const pg8::ss_t* ss, const float* g, bf16* P, int t0, int lane) {
    constexpr int HW = 1 << GI, W = 2 * HW, NR = 15 + W, ELT = F32IN ? 4 : 2;
    const int bstart = t0 & ~(SEQ - 1), c = GI * 256 + lane * 4;
    float myrs; { const int myrow = t0 - HW + lane, myrc = min(max(myrow, bstart), bstart + SEQ - 1);
        myrs = (myrow == myrc) ? pg8::ss_rsqrt(ss, myrc) : 0.f; }
    f32x4 r[NR];
    int rc = max(t0 - HW, bstart);
    const char* p = (const char*)(F32IN ? (const void*)xf : (const void*)xb) + ((size_t)rc * DM + c) * ELT;
#pragma unroll
    for (int k = 0; k < NR; ++k) {
        if (F32IN) r[k] = *(const __attribute__((address_space(1))) f32x4*)p;
        else { const v2u w = *(const __attribute__((address_space(1))) v2u*)p; r[k] = (f32x4){bf_lo(w.x), bf_hi(w.x), bf_lo(w.y), bf_hi(w.y)}; }
        const int rcn = min(max(t0 - HW + k + 1, bstart), bstart + SEQ - 1);
        p += (size_t)(rcn - rc) * (DM * ELT); rc = rcn; asm volatile("" : "+v"(p)); }
    const f32x4 g4 = *(const f32x4*)(g + c);
#pragma unroll
    for (int k = 0; k < NR; ++k) r[k] = r[k] * __builtin_bit_cast(float, __builtin_amdgcn_readlane(__builtin_bit_cast(int, myrs), k));
    f32x4 S = r[0];
#pragma unroll
    for (int k = 1; k < W; ++k) S += r[k];
    bf16* q = P + (size_t)t0 * DM + c;
#pragma unroll
    for (int tt = 0; tt < 16; ++tt) { const int tl = t0 + tt - bstart; const int cnt = min(tl + HW, SEQ) - max(tl - HW, 0);
        const f32x4 p4 = (S * (1.0f / (float)cnt) - r[tt + HW]) * g4;
        v2u w; w.x = pk2(p4.x, p4.y); w.y = pk2(p4.z, p4.w);
        *(__attribute__((address_space(1))) v2u*)q = w; q += DM; asm volatile("" : "+v"(q));
        if (tt < 15) S += r[tt + W] - r[tt]; }
}
template <bool F32IN, int GI>
__device__ __forceinline__ void pool_loop(const float* x0, const float* x1, const bf16* xb, const pg8::ss_t* ss, const float* g, bf16* P, int gw, int NGW, int lane) {
    const int nitems = (M_TOT / 16) * 4;
    for (int it = gw; it < nitems; it += NGW) { const int t0 = (it >> 2) * 16;
        const float* xf = F32IN ? ((t0 < 4 * SEQ) ? x0 : x1 - (size_t)4 * SEQ * DM) : nullptr;
        pool_item<F32IN, GI>(xf, xb, ss, g, P, t0, lane); }
}
template <bool F32IN>
__device__ __forceinline__ void pool_prep(const float* x0, const float* x1, const bf16* xb, const pg8::ss_t* ss, const float* g, bf16* P, int gw, int NGW, int lane) {
    const int gi = gw & 3;
    if (gi == 0) pool_loop<F32IN, 0>(x0, x1, xb, ss, g, P, gw, NGW, lane);
    else if (gi == 1) pool_loop<F32IN, 1>(x0, x1, xb, ss, g, P, gw, NGW, lane);
    else if (gi == 2) pool_loop<F32IN, 2>(x0, x1, xb, ss, g, P, gw, NGW, lane);
    else pool_loop<F32IN, 3>(x0, x1, xb, ss, g, P, gw, NGW, lane);
}

#define XB_TMO      128
#define XB_XCNT(j)  (256  + 64 * (j))
#define XB_XSUB(j)  (1280 + 64 * (j))
#define XB_XGEN(j)  (2304 + 64 * (j))
#define XB_TOP      3328
#define XB_TOPGEN   3392
#define XCD_BAR_WORDS 3456
#define XB_SPIN_CAP (1u << 18)
__device__ __forceinline__ unsigned xb_ld(unsigned* p)              { return __hip_atomic_load(p, __ATOMIC_RELAXED, __HIP_MEMORY_SCOPE_AGENT); }
__device__ __forceinline__ unsigned xb_add(unsigned* p, unsigned v) { return __hip_atomic_fetch_add(p, v, __ATOMIC_RELAXED, __HIP_MEMORY_SCOPE_AGENT); }
__device__ __forceinline__ unsigned xb_xcc_id() { return (unsigned)__builtin_amdgcn_s_getreg((3 << 11) | 20) & 0xFu; }
#define XB_SPIN(cond, bar) do { unsigned _sp = 0; while (cond) { __builtin_amdgcn_s_sleep(1); \
    if ((++_sp & 255u) == 0u) { if (xb_ld(&(bar)[XB_TMO])) break; if (_sp > XB_SPIN_CAP) { atomicAdd(&(bar)[XB_TMO], 1u); break; } } } } while (0)
__device__ __forceinline__ void xcd_barrier_complete(unsigned* bar, unsigned x, unsigned& nloc, unsigned& nx) {
    const unsigned G = gridDim.x * gridDim.y * gridDim.z;
    unsigned sum, cnt, mine, sp = 0u;
    for (;;) {
        sum = 0u; cnt = 0u; mine = 0u;
#pragma unroll
        for (unsigned j = 0; j < 16; ++j) { const unsigned c = xb_ld(&bar[XB_XCNT(j)]); sum += c; cnt += (c > 0u) ? 1u : 0u; mine = (j == x) ? c : mine; }
        if (sum == G) break;
        __builtin_amdgcn_s_sleep(1);
        if ((++sp & 255u) == 0u) { if (xb_ld(&bar[XB_TMO])) break; if (sp > XB_SPIN_CAP) { atomicAdd(&bar[XB_TMO], 1u); break; } }
    }
    nloc = mine > 0u ? mine : 1u; nx = cnt > 0u ? cnt : 1u;
}
__device__ __forceinline__ void xcd_barrier(unsigned* bar, volatile LAS unsigned* st) {
    asm volatile("s_waitcnt vmcnt(0)" ::: "memory");
    __syncthreads();
    if (threadIdx.x == 0) {
        const unsigned x = xb_xcc_id();
        __builtin_amdgcn_s_waitcnt(0);
        unsigned nloc = st[0], nx = st[1];
        if (nloc == 0u) { xcd_barrier_complete(bar, x, nloc, nx); st[0] = nloc; st[1] = nx; }
        const unsigned old = xb_add(&bar[XB_XSUB(x)], 1u);
        const unsigned gen = old / nloc;
        if (old + 1u == (gen + 1u) * nloc) {
            __builtin_amdgcn_fence(__ATOMIC_RELEASE, "agent");
            asm volatile("s_waitcnt vmcnt(0)" ::: "memory");
            const unsigned og = xb_add(&bar[XB_TOP], 1u);
            const unsigned tg = og / nx;
            if (og + 1u == (tg + 1u) * nx) xb_add(&bar[XB_TOPGEN], 1u);
            else XB_SPIN(xb_ld(&bar[XB_TOPGEN]) == tg, bar);
            __builtin_amdgcn_fence(__ATOMIC_ACQUIRE, "agent");
            xb_add(&bar[XB_XGEN(x)], 1u);
            asm volatile("s_waitcnt vmcnt(0)" ::: "memory");
        } else {
            XB_SPIN(xb_ld(&bar[XB_XGEN(x)]) == gen, bar);
            __builtin_amdgcn_fence(__ATOMIC_ACQUIRE, "agent");
            asm volatile("s_waitcnt vmcnt(0)" ::: "memory");
        }
    }
    __syncthreads();
}

__device__ __forceinline__ KArgs kargs() { KArgs p = (KArgs)__builtin_amdgcn_kernarg_segment_ptr(); asm volatile("" : "+s"(p)); return p; }
struct Ctx { int G, bx, vcu, gw, NGW, wave, lane; };
__device__ __forceinline__ Ctx ctx() { Ctx c; const int tid = tid_l(); c.lane = tid & 63; c.wave = __builtin_amdgcn_readfirstlane(tid >> 6); c.G = gridDim.x; c.bx = blockIdx.x;
    c.vcu = (c.G % 8 == 0) ? (c.bx % 8) * (c.G / 8) + c.bx / 8 : c.bx;
    c.gw = c.vcu * NWAVES + c.wave; c.NGW = c.G * NWAVES; return c; }

__device__ __forceinline__ void ph_prologue(LAS unsigned char* L) { KArgs ka = kargs(); const Ctx c = ctx(); p0_prologue(ka, L, c.gw, c.NGW, c.wave, c.lane); }
__device__ __forceinline__ void ph_pool_prep(int layer) { KArgs ka = kargs(); const Ctx c = ctx(); unsigned char* ws = ka->ws;
    const pg8::ss_t* ss_mix = (const pg8::ss_t*)(ws + WS_SS) + (size_t)(2 * layer) * M_TOT;
    if (layer == 0) pool_prep<true>(ka->in[0], ka->in[1], (const bf16*)(ws + WS_XB), ss_mix, ka->in[2] + layer * DM, (bf16*)(ws + WS_P), c.gw, c.NGW, c.lane);
    else pool_prep<false>(nullptr, nullptr, (const bf16*)(ws + WS_XB), ss_mix, ka->in[2] + layer * DM, (bf16*)(ws + WS_P), c.gw, c.NGW, c.lane); }
__device__ __forceinline__ void ph_qkv(LAS unsigned char* L, int layer) { KArgs ka = kargs(); const Ctx c = ctx(); unsigned char* ws = ka->ws; const int j = layer >> 1;
    pg8::Gemm g{(const bf16*)(ws + WS_XB), (const bf16*)(ws + WS_WQKV) + (size_t)j * NQKV * DM, M_TOT, NQKV, DM, DM, DM, 0}; pg8::StaticOrder S; S.init(M_TOT, NQKV, c.G, c.bx);
    pg8::EpiQKV E{(bf16*)(ws + WS_QKV), (bf16*)(ws + WS_KC), (bf16*)(ws + WS_VC), (const pg8::ss_t*)(ws + WS_SS) + (size_t)(2 * layer) * M_TOT, ka->in[8] + j * HD, ka->in[9] + j * HD, (const LAS float*)(L + 131072 + 10240), (LAS float*)(L + 131072 + 1024)};
    { const int tid = tid_l(); const v4u* src = (const v4u*)(ws + WS_ROPE); LAS v4u* dst = (LAS v4u*)(L + 131072 + 10240);
      dst[tid] = src[tid]; dst[tid + 512] = src[tid + 512]; LDS_WAIT(); }
    pg8::gemm_phase<pg8::EpiQKV, pg8::StaticOrder>(L, g, S, E);
}
__device__ __forceinline__ void ph_attn(unsigned char* lds, int layer) { KArgs ka = kargs(); const Ctx c = ctx(); unsigned char* ws = ka->ws;
    const float bound = ((const float*)(ws + WS_BOUND))[layer >> 1]; const bool bounded = bound < 40.f;
    bf16* QB = (bf16*)(ws + WS_QKV); bf16* KC = (bf16*)(ws + WS_KC); bf16* VC = (bf16*)(ws + WS_VC); bf16* OB = (bf16*)(ws + WS_O);
    for (int U = c.vcu; U < NB_TOT * 2 * 64; U += c.G) {
        int grp, uu;
        if (c.G == 256) { const int i = U >> 8, xcd = c.vcu >> 5, loc = c.vcu & 31; grp = xcd + 8 * (i >> 1); uu = (i & 1) * 32 + loc; }
        else { grp = U >> 6; uu = U & 63; }
        const int b = grp >> 1, kvh = grp & 1, head = kvh * 4 + (uu >> 4), qb = uu & 15;
        const size_t rowb = (size_t)b * SEQ, row0 = rowb + (size_t)qb * 256;
        if (bounded) attn::attn_dense_body<true>((const attn::bf16*)(QB + row0 * DM + head * HD), (const attn::bf16*)(KC + (size_t)grp * SEQ * HD),
                              (const attn::bf16*)(VC + (size_t)grp * SEQ * HD), OB + row0 * DM + head * HD, SEQ, (char*)lds);
        else attn::attn_dense_body<false>((const attn::bf16*)(QB + row0 * DM + head * HD), (const attn::bf16*)(KC + (size_t)grp * SEQ * HD),
                              (const attn::bf16*)(VC + (size_t)grp * SEQ * HD), OB + row0 * DM + head * HD, SEQ, (char*)lds);
    } }
__device__ __forceinline__ void ph_mix(LAS unsigned char* L, int layer) { KArgs ka = kargs(); const Ctx c = ctx(); unsigned char* ws = ka->ws; const int j = layer >> 1;
    pg8::Gemm g; const float* mbias = nullptr; const float* mscale = nullptr;
    if ((layer & 1) == 0) { g = pg8::Gemm{(const bf16*)(ws + WS_P), (const bf16*)(ws + WS_WP) + (size_t)j * DM * 256, M_TOT, DM, 256, DM, 256, 256}; mbias = ka->in[5] + j * DM; mscale = ka->in[6] + j * DM; }
    else g = pg8::Gemm{(const bf16*)(ws + WS_O), (const bf16*)(ws + WS_WO) + (size_t)j * DM * DM, M_TOT, DM, DM, DM, DM, 0};
    pg8::StaticOrder S; S.init(M_TOT, DM, c.G, c.bx);
    const float* b_lo = (layer == 0) ? ka->in[0] : nullptr; const float* b_hi = (layer == 0) ? ka->in[1] - (size_t)4 * SEQ * DM : nullptr;
    pg8::EpiRes E{b_lo, b_hi, 4 * SEQ / 256, nullptr, (bf16*)(ws + WS_XB), (pg8::ss_t*)(ws + WS_SS) + (size_t)(2 * layer + 1) * M_TOT, mbias, mscale};
    pg8::gemm_phase<pg8::EpiRes, pg8::StaticOrder>(L, g, S, E);
}
__device__ __forceinline__ void ph_gateup(LAS unsigned char* L, int layer) { KArgs ka = kargs(); const Ctx c = ctx(); unsigned char* ws = ka->ws;
    pg8::Gemm g{(const bf16*)(ws + WS_XB), (const bf16*)(ws + WS_WGU) + (size_t)layer * NGU * DM, M_TOT, NGU, DM, DM, DM, 0}; pg8::StaticOrder S; S.init(M_TOT, NGU, c.G, c.bx);
    pg8::EpiSwiGLU E{(bf16*)(ws + WS_H), (const pg8::ss_t*)(ws + WS_SS) + (size_t)(2 * layer + 1) * M_TOT};
    pg8::gemm_phase<pg8::EpiSwiGLU, pg8::StaticOrder>(L, g, S, E);
}
__device__ __forceinline__ void ph_down(LAS unsigned char* L, int layer) { KArgs ka = kargs(); const Ctx c = ctx(); unsigned char* ws = ka->ws;
    pg8::Gemm g{(const bf16*)(ws + WS_H), (const bf16*)(ws + WS_WD) + (size_t)layer * DM * DFF, M_TOT, DM, DFF, DFF, DFF, 0}; pg8::StaticOrder S; S.init(M_TOT, DM, c.G, c.bx);
    pg8::EpiRes E{nullptr, nullptr, 0, (layer < 3) ? nullptr : ka->out, (bf16*)(ws + WS_XB), (layer < 3) ? (pg8::ss_t*)(ws + WS_SS) + (size_t)(2 * layer + 2) * M_TOT : nullptr, nullptr, nullptr};
    pg8::gemm_phase<pg8::EpiRes, pg8::StaticOrder>(L, g, S, E);
}

__global__ void __launch_bounds__(NWAVES * 64, 2) mk_fwd(Args args) {
    extern __shared__ __attribute__((aligned(16))) unsigned char lds[];
    cg::grid_group grid = cg::this_grid();
    LAS unsigned char* L = (LAS unsigned char*)lds;
    const int lo = args.ph_lo, hi = args.ph_hi;
    if (threadIdx.x < 2) ((volatile LAS unsigned*)(L + 131072 + 256))[threadIdx.x] = 0u;
    __syncthreads();
    if (MK_N_LAUNCHES == 1 && threadIdx.x == 0) (void)xb_add((unsigned*)(args.ws + WS_BAR) + XB_XCNT(xb_xcc_id()), 1u);
#define RUN(k) (lo <= (k) && (k) < hi)
#define SEAM(k) do { if (RUN(k) && RUN((k) + 1)) { KArgs ka_ = kargs(); xcd_barrier((unsigned*)(ka_->ws + WS_BAR), (volatile LAS unsigned*)(L + 131072 + 256)); } } while (0)
    int ph = 0;
    if (RUN(ph)) ph_prologue(L);
    if (args.ph_lo < -1) grid.sync();
    SEAM(ph);
    ++ph;
    for (int layer = 0; layer < 4; ++layer) {
        if ((layer & 1) == 0) {
            if (RUN(ph)) ph_pool_prep(layer);
            SEAM(ph); ++ph;
        } else {
            if (RUN(ph)) ph_qkv(L, layer);
            SEAM(ph); ++ph;
            if (RUN(ph)) ph_attn(lds, layer);
            SEAM(ph); ++ph;
        }
        if (RUN(ph)) ph_mix(L, layer);
        SEAM(ph); ++ph;
        if (RUN(ph)) ph_gateup(L, layer);
        SEAM(ph); ++ph;
        if (RUN(ph)) ph_down(L, layer);
        SEAM(ph); ++ph;
    }
#undef RUN
#undef SEAM
}

extern "C" void kernel_launch(void* const* d_in, const int* in_sizes, int n_in, void* d_out, int out_size, void* d_ws, size_t ws_size, hipStream_t stream) {
    static int grid = 0;
    if (grid == 0) {
        if (n_in != 13 || in_sizes[0] != 4 * SEQ * DM || in_sizes[1] != 8 * SEQ * DM || out_size != M_TOT * DM || ws_size < WS_END) {
            fprintf(stderr, "kernel_launch: shape mismatch n_in %d in0 %d in1 %d out %d ws %zu\n", n_in, n_in > 0 ? in_sizes[0] : -1, n_in > 1 ? in_sizes[1] : -1, out_size, ws_size); grid = -1; return; }
        int dev = 0, cus = 0, per_cu = 0;
        if (hipGetDevice(&dev) != hipSuccess || hipDeviceGetAttribute(&cus, hipDeviceAttributeMultiprocessorCount, dev) != hipSuccess) { grid = -1; return; }
        if (hipFuncSetAttribute((const void*)mk_fwd, hipFuncAttributeMaxDynamicSharedMemorySize, LDS_BYTES) != hipSuccess) { fprintf(stderr, "kernel_launch: hipFuncSetAttribute failed\n"); grid = -1; return; }
        if (hipOccupancyMaxActiveBlocksPerMultiprocessor(&per_cu, (const void*)mk_fwd, NWAVES * 64, LDS_BYTES) != hipSuccess || per_cu < 1) { fprintf(stderr, "kernel_launch: occupancy query says %d\n", per_cu); per_cu = 1; }
        (void)hipGetLastError();
        grid = cus * (per_cu > 1 ? 1 : per_cu);
    }
    if (grid < 0) return;
    if (hipMemsetAsync((char*)d_ws + WS_BAR, 0, 16384, stream) != hipSuccess) { fprintf(stderr, "kernel_launch: memset of the barrier words failed\n"); return; }
    Args a{};
    for (int i = 0; i < 13; ++i) a.in[i] = (const float*)d_in[i];
    a.out = (float*)d_out; a.ws = (unsigned char*)d_ws;
#if MK_N_LAUNCHES == 1
    a.ph_lo = 0; a.ph_hi = N_PHASES;
    void* kargs[] = {&a};
    hipError_t e = hipLaunchCooperativeKernel((const void*)mk_fwd, dim3(grid), dim3(NWAVES * 64), kargs, LDS_BYTES, stream);
    if (e != hipSuccess) fprintf(stderr, "kernel_launch: cooperative launch failed: %s (grid %d)\n", hipGetErrorString(e), grid);
#else
    for (int p = 0; p < N_PHASES; ++p) { a.ph_lo = p; a.ph_hi = p + 1;
        hipLaunchKernelGGL(mk_fwd, dim3(grid), dim3(NWAVES * 64), LDS_BYTES, stream, a);
        const hipError_t le = hipPeekAtLastError();
        if (le != hipSuccess) { fprintf(stderr, "kernel_launch: launch %d failed: %s\n", p, hipGetErrorName(le)); break; } }
#endif
}
```

```cpp
#include <hip/hip_runtime.h>
#include <hip/hip_bf16.h>
#include <hip/hip_cooperative_groups.h>
#include <cstdio>
#include <cstdint>
namespace cg = cooperative_groups;

#ifndef MK_N_LAUNCHES
#define MK_N_LAUNCHES 1
#endif

constexpr int DM = 1024, SEQ = 4096, NB_TOT = 12, M_TOT = NB_TOT * SEQ;
constexpr int DFF = 2816, NGU = 2 * DFF, NQKV = 1536, HD = 128;
constexpr float EPS = 1e-6f;
constexpr int N_PHASES = 19;

constexpr size_t MiB = 1u << 20;
constexpr size_t WS_ROPE = 0;
constexpr size_t WS_BOUND = 32768;
constexpr size_t WS_BAR = 2 * MiB - 65536;
constexpr size_t WS_WGU = 2 * MiB;
constexpr size_t WS_WD = 46 * MiB;
constexpr size_t WS_WQKV = 68 * MiB;
constexpr size_t WS_WO = 74 * MiB;
constexpr size_t WS_WP = 78 * MiB;
constexpr size_t WS_XB = 80 * MiB;
constexpr size_t WS_H = 176 * MiB;
constexpr size_t WS_QKV = 176 * MiB;
constexpr size_t WS_KC = 272 * MiB;
constexpr size_t WS_VC = 296 * MiB;
constexpr size_t WS_O = 320 * MiB;
constexpr size_t WS_P = 176 * MiB;
constexpr size_t WS_SS = 440 * MiB;
constexpr size_t WS_END = 444 * MiB;
static_assert(WS_ROPE + 64 * 32 * 8 <= WS_BAR && WS_BAR + 16384 <= WS_WGU && WS_WGU + (size_t)4 * NGU * DM * 2 <= WS_WD && WS_WD + (size_t)4 * DM * DFF * 2 <= WS_WQKV, "ws map 1");
static_assert(WS_WQKV + (size_t)2 * NQKV * DM * 2 <= WS_WO && WS_WO + (size_t)2 * DM * DM * 2 <= WS_WP && WS_WP + (size_t)2 * DM * 256 * 2 <= WS_XB, "ws map 2");
static_assert(WS_XB + (size_t)M_TOT * DM * 2 <= WS_H && WS_H + (size_t)M_TOT * DFF * 2 <= WS_SS && WS_SS + (size_t)8 * M_TOT * 8 <= WS_END && WS_QKV + (size_t)M_TOT * DM * 2 <= WS_KC && WS_KC + (size_t)M_TOT * 256 * 2 <= WS_VC && WS_VC + (size_t)M_TOT * 256 * 2 <= WS_O && WS_O + (size_t)M_TOT * DM * 2 <= WS_END, "ws map 3");

__device__ __forceinline__ int tid_l() { int t = threadIdx.x; asm volatile("" : "+v"(t)); return t; }
constexpr int LDS_BYTES = 131072 + 26624;
constexpr int NWAVES = 8;

namespace pg8 {
#define PG8_LAS __attribute__((address_space(3)))
typedef unsigned short bf16_t;
typedef short bf16x8 __attribute__((ext_vector_type(8)));
typedef float f32x4 __attribute__((ext_vector_type(4)));
typedef unsigned u32x4 __attribute__((ext_vector_type(4)));
typedef unsigned u32x2 __attribute__((ext_vector_type(2)));
constexpr int BM = 256, BK = 64, HALF = 128, HTB = HALF * BK * 2, STAGE_BYTES = 8 * HTB, NXCD = 8, WGM = 8;

__host__ __device__ __forceinline__ int lds_byte(int r, int c) { const int st = (r >> 4) * 2 + (c >> 5), rr = r & 15, cc = c & 31, ob = rr * 64 + cc * 2; return st * 1024 + (ob ^ (((ob >> 9) & 1) << 5)); }
__host__ __device__ __forceinline__ void stage_rc(int b, int& R, int& C) { const int st = b / 1024, sb = b % 1024, swz = sb ^ (((sb >> 9) & 1) << 5); R = (st >> 1) * 16 + swz / 64; C = (st & 1) * 32 + (swz % 64) / 2; }
__host__ __device__ __forceinline__ int perm32(int rho) { const int n = rho >> 4, i = rho & 15; return 8 * (i >> 2) + 4 * n + (i & 3); }

struct Unit { int pm, pn; };
struct Gemm { const bf16_t* A; const bf16_t* Bt; int M, N, K, lda, ldb, a_pn_cols; };

struct StaticOrder {
    int nM, nN, nwg, G, c;
    __host__ __device__ void init(int M, int N, int G_, int c_) { nM = M / BM; nN = N / BM; nwg = nM * nN; G = G_; c = c_; }
    __host__ __device__ bool next(int i, Unit& u) const {
        const long L = (long)i * G + c; if (L >= nwg) return false;
        int wgid = (int)L; { const int q = nwg / NXCD, r = nwg % NXCD, xcd = wgid % NXCD, off = wgid / NXCD; wgid = (xcd < r ? xcd * (q + 1) : r * (q + 1) + (xcd - r) * q) + off; }
        const int nig = WGM * nN, gid = wgid / nig, fm = gid * WGM, gsz = (nM - fm) < WGM ? (nM - fm) : WGM;
        u.pm = fm + ((wgid % nig) % gsz); u.pn = (wgid % nig) / gsz; return true;
    }
};

__device__ __forceinline__ unsigned cvt_pk_bf16(float lo, float hi) { unsigned r; asm("v_cvt_pk_bf16_f32 %0, %1, %2" : "=v"(r) : "v"(lo), "v"(hi)); return r; }
typedef unsigned long long ss_t;
__device__ __forceinline__ float ss_rsqrt(const ss_t* ss, int row) { return __builtin_amdgcn_rsqf((float)ss[row] * (1.0f / 16777216.0f / DM) + EPS); }
__device__ __forceinline__ ss_t ss_fix(float sq) { return (ss_t)(sq * 16777216.0f + 0.5f); }
__device__ __forceinline__ void ss_rsqrt8(const ss_t* ss, int row0, float (&r)[2][4]) {
    ss_t v[2][4];
#pragma unroll
    for (int ai = 0; ai < 2; ++ai)
#pragma unroll
        for (int m = 0; m < 4; ++m) v[ai][m] = ss[row0 + ai * HALF + m * 16];
#pragma unroll
    for (int ai = 0; ai < 2; ++ai)
#pragma unroll
        for (int m = 0; m < 4; ++m) r[ai][m] = __builtin_amdgcn_rsqf((float)v[ai][m] * (1.0f / 16777216.0f / DM) + EPS);
}


struct EpiQKV {
    static constexpr bool PERM = true;
    bf16_t* Q; bf16_t* Kc; bf16_t* Vc; const ss_t* ss; const float* q_gain; const float* k_gain; const PG8_LAS float* rope; PG8_LAS float* part;
    __device__ __forceinline__ static size_t kv_off(int row, int bj) { return ((size_t)((row >> 12) * 2 + bj) * SEQ + (row & (SEQ - 1))) * HD; }
    __device__ __forceinline__ void operator()(const f32x4 (&acc)[2][2][4][2], const Unit& u, int wr, int wc, int fr, int fq) const {
        const int row0 = u.pm * BM + wr * 64 + fr, col0 = u.pn * BM + wc * 32 + 8 * fq;
        if (u.pn >= 5) {
#pragma unroll
            for (int ai = 0; ai < 2; ++ai)
#pragma unroll
                for (int m = 0; m < 4; ++m) { const int row = row0 + ai * HALF + m * 16; const float r = ss_rsqrt(ss, row);
#pragma unroll
                    for (int bj = 0; bj < 2; ++bj) { const f32x4 v0 = acc[ai][bj][m][0] * r, v1 = acc[ai][bj][m][1] * r;
                        u32x4 w; w.x = cvt_pk_bf16(v0[0], v0[1]); w.y = cvt_pk_bf16(v0[2], v0[3]); w.z = cvt_pk_bf16(v1[0], v1[1]); w.w = cvt_pk_bf16(v1[2], v1[3]);
                        *(u32x4*)(Vc + kv_off(row, bj) + wc * 32 + 8 * fq) = w; } }
            return;
        }
        float rr[2][4];
#pragma unroll
        for (int ai = 0; ai < 2; ++ai)
#pragma unroll
            for (int m = 0; m < 4; ++m) { const int rl = ai * HALF + wr * 64 + m * 16 + fr; const float r = ss_rsqrt(ss, u.pm * BM + rl); rr[ai][m] = r;
#pragma unroll
                for (int bj = 0; bj < 2; ++bj) { const f32x4 a = acc[ai][bj][m][0], b = acc[ai][bj][m][1];
                    float sq = ((a[0] * a[0] + a[1] * a[1]) + (a[2] * a[2] + a[3] * a[3])) + ((b[0] * b[0] + b[1] * b[1]) + (b[2] * b[2] + b[3] * b[3]));
                    sq += __shfl_xor(sq, 16); sq += __shfl_xor(sq, 32);
                    if (fq == 0) part[(rl * 2 + bj) * 4 + wc] = sq * r * r; } }
        asm volatile("s_waitcnt lgkmcnt(0)" ::: "memory"); __builtin_amdgcn_s_barrier(); asm volatile("" ::: "memory");
        const int half = wc >> 1, ib = (wc & 1) * 16 + 4 * fq; const float qsc = (u.pn == 4) ? 1.0f : 0.12752041570284543f;
        const float* gn = (u.pn == 4 ? k_gain : q_gain) + half * 64 + ib;
        const f32x4 g1 = *(const f32x4*)gn, g2 = *(const f32x4*)(gn + 32);
#pragma unroll
        for (int ai = 0; ai < 2; ++ai)
#pragma unroll
            for (int m = 0; m < 4; ++m) { const int rl = ai * HALF + wr * 64 + m * 16 + fr, row = u.pm * BM + rl, t = row & (SEQ - 1), pos = half ? (t & 63) : (t >> 6);
                const f32x4 cs01 = *(const PG8_LAS f32x4*)(rope + (pos * 32 + ib) * 2), cs23 = *(const PG8_LAS f32x4*)(rope + (pos * 32 + ib) * 2 + 4);
#pragma unroll
                for (int bj = 0; bj < 2; ++bj) { const f32x4 p4 = *(const PG8_LAS f32x4*)(part + (rl * 2 + bj) * 4);
                    bf16_t* dst = (u.pn == 4) ? Kc + kv_off(row, bj) + wc * 32 + 8 * fq : Q + (size_t)row * DM + col0 + bj * HALF;
                    const float rn = __builtin_amdgcn_rsqf(((p4[0] + p4[1]) + (p4[2] + p4[3])) * (1.0f / HD) + EPS) * rr[ai][m] * qsc;
                    const f32x4 a = acc[ai][bj][m][0] * rn, b = acc[ai][bj][m][1] * rn;
                    const float x10 = a[0] * g1[0], x20 = a[1] * g2[0], x11 = a[2] * g1[1], x21 = a[3] * g2[1], x12 = b[0] * g1[2], x22 = b[1] * g2[2], x13 = b[2] * g1[3], x23 = b[3] * g2[3];
                    u32x4 w;
                    w.x = cvt_pk_bf16(x10 * cs01[0] - x20 * cs01[1], x20 * cs01[0] + x10 * cs01[1]);
                    w.y = cvt_pk_bf16(x11 * cs01[2] - x21 * cs01[3], x21 * cs01[2] + x11 * cs01[3]);
                    w.z = cvt_pk_bf16(x12 * cs23[0] - x22 * cs23[1], x22 * cs23[0] + x12 * cs23[1]);
                    w.w = cvt_pk_bf16(x13 * cs23[2] - x23 * cs23[3], x23 * cs23[2] + x13 * cs23[3]);
                    *(u32x4*)dst = w; } }
    }
};
struct EpiSwiGLU {
    static constexpr bool PERM = true;
    bf16_t* H; const ss_t* ss;
    __device__ __forceinline__ void operator()(const f32x4 (&acc)[2][2][4][2], const Unit& u, int wr, int wc, int fr, int fq) const {
        const int row0 = u.pm * BM + wr * 64 + fr, col0 = u.pn * HALF + wc * 32 + 8 * fq;
        float rr[2][4]; ss_rsqrt8(ss, row0, rr);
#pragma unroll
        for (int ai = 0; ai < 2; ++ai)
#pragma unroll
            for (int m = 0; m < 4; ++m) { const int row = row0 + ai * HALF + m * 16; const float r = rr[ai][m];
                typedef float f32x2 __attribute__((ext_vector_type(2)));
                const float rn = r * -1.4426950408889634f, r2 = r * r;
                unsigned hw[4];
#pragma unroll
                for (int n = 0; n < 2; ++n)
#pragma unroll
                    for (int jp = 0; jp < 2; ++jp) { const f32x2 g = {acc[ai][0][m][n][2 * jp], acc[ai][0][m][n][2 * jp + 1]}, uu = {acc[ai][1][m][n][2 * jp], acc[ai][1][m][n][2 * jp + 1]};
                        const f32x2 t = g * rn; f32x2 e; e.x = __builtin_amdgcn_exp2f(t.x); e.y = __builtin_amdgcn_exp2f(t.y);
                        const f32x2 d = e + 1.0f; f32x2 rc; rc.x = __builtin_amdgcn_rcpf(d.x); rc.y = __builtin_amdgcn_rcpf(d.y);
                        const f32x2 h = (g * uu) * (rc * r2);
                        hw[n * 2 + jp] = cvt_pk_bf16(h.x, h.y); }
                u32x4 w; w.x = hw[0]; w.y = hw[1]; w.z = hw[2]; w.w = hw[3];
                *(u32x4*)(H + (size_t)row * DFF + col0) = w; }
    }
};
struct EpiRes {
    static constexpr bool PERM = true;
    const float* xin_lo; const float* xin_hi; int split_pm; float* out; bf16_t* xb; ss_t* ss; const float* bias; const float* scale;
    template <bool F32, int NM>
    __device__ __forceinline__ void rows(const f32x4 (&acc)[2][2][4][2], const float* xin, int ai, int m0, int row0, int col0, int fq, const f32x4 (&bv)[2][2], const f32x4 (&sv)[2][2]) const {
        const size_t off0 = (size_t)(row0 + ai * HALF + m0 * 16) * DM + col0;
        f32x4 b[NM][2][2];
        if (F32) {
#pragma unroll
            for (int m = 0; m < NM; ++m)
#pragma unroll
                for (int bj = 0; bj < 2; ++bj)
#pragma unroll
                    for (int n = 0; n < 2; ++n) b[m][bj][n] = *(const f32x4*)(xin + off0 + (size_t)m * 16 * DM + bj * HALF + 4 * n);
        } else {
            u32x4 w[NM][2];
#pragma unroll
            for (int m = 0; m < NM; ++m)
#pragma unroll
                for (int bj = 0; bj < 2; ++bj) w[m][bj] = *(const u32x4*)(xb + off0 + (size_t)m * 16 * DM + bj * HALF);
#pragma unroll
            for (int m = 0; m < NM; ++m)
#pragma unroll
                for (int bj = 0; bj < 2; ++bj) {
                    b[m][bj][0] = (f32x4){__builtin_bit_cast(float, w[m][bj].x << 16), __builtin_bit_cast(float, w[m][bj].x & 0xffff0000u), __builtin_bit_cast(float, w[m][bj].y << 16), __builtin_bit_cast(float, w[m][bj].y & 0xffff0000u)};
                    b[m][bj][1] = (f32x4){__builtin_bit_cast(float, w[m][bj].z << 16), __builtin_bit_cast(float, w[m][bj].z & 0xffff0000u), __builtin_bit_cast(float, w[m][bj].w << 16), __builtin_bit_cast(float, w[m][bj].w & 0xffff0000u)}; }
        }
#pragma unroll
        for (int m = 0; m < NM; ++m) { const int row = row0 + ai * HALF + (m0 + m) * 16; const size_t off = off0 + (size_t)m * 16 * DM; float sq = 0.f;
#pragma unroll
            for (int bj = 0; bj < 2; ++bj) { f32x4 o[2];
#pragma unroll
                for (int n = 0; n < 2; ++n) { f32x4 v = acc[ai][bj][m0 + m][n];
                    if (bias) v = (v + bv[bj][n]) * sv[bj][n];
                    o[n] = b[m][bj][n] + v;
                    sq += (o[n][0] * o[n][0] + o[n][1] * o[n][1]) + (o[n][2] * o[n][2] + o[n][3] * o[n][3]); }
                if (out) { *(f32x4*)(out + off + bj * HALF) = o[0]; *(f32x4*)(out + off + bj * HALF + 4) = o[1]; }
                else { u32x4 w; w.x = cvt_pk_bf16(o[0][0], o[0][1]); w.y = cvt_pk_bf16(o[0][2], o[0][3]); w.z = cvt_pk_bf16(o[1][0], o[1][1]); w.w = cvt_pk_bf16(o[1][2], o[1][3]); *(u32x4*)(xb + off + bj * HALF) = w; } }
            if (ss) { sq += __shfl_xor(sq, 16); sq += __shfl_xor(sq, 32); if (fq == 0) atomicAdd(ss + row, ss_fix(sq)); } }
        asm volatile("" ::: "memory");
    }
    __device__ __forceinline__ void operator()(const f32x4 (&acc)[2][2][4][2], const Unit& u, int wr, int wc, int fr, int fq) const {
        const int col0 = u.pn * BM + wc * 32 + 8 * fq, row0 = u.pm * BM + wr * 64 + fr;
        const float* xin = (u.pm < split_pm) ? xin_lo : xin_hi;
        f32x4 bv[2][2], sv[2][2];
#pragma unroll
        for (int bj = 0; bj < 2; ++bj)
#pragma unroll
            for (int n = 0; n < 2; ++n) { bv[bj][n] = bias ? *(const f32x4*)(bias + col0 + bj * HALF + 4 * n) : (f32x4){0.f, 0.f, 0.f, 0.f}; sv[bj][n] = bias ? *(const f32x4*)(scale + col0 + bj * HALF + 4 * n) : (f32x4){1.f, 1.f, 1.f, 1.f}; }
        if (xin) {
#pragma unroll
            for (int ai = 0; ai < 2; ++ai) { rows<true, 2>(acc, xin, ai, 0, row0, col0, fq, bv, sv); rows<true, 2>(acc, xin, ai, 2, row0, col0, fq, bv, sv); }
        } else if (bias) {
#pragma unroll
            for (int ai = 0; ai < 2; ++ai) rows<false, 4>(acc, xin, ai, 0, row0, col0, fq, bv, sv);
        } else {
            u32x4 w[2][4][2];
#pragma unroll
            for (int ai = 0; ai < 2; ++ai)
#pragma unroll
                for (int m = 0; m < 4; ++m)
#pragma unroll
                    for (int bj = 0; bj < 2; ++bj) w[ai][m][bj] = *(const u32x4*)(xb + (size_t)(row0 + ai * HALF + m * 16) * DM + col0 + bj * HALF);
#pragma unroll
            for (int ai = 0; ai < 2; ++ai)
#pragma unroll
                for (int m = 0; m < 4; ++m) { const int row = row0 + ai * HALF + m * 16; const size_t off = (size_t)row * DM + col0; float sq = 0.f;
#pragma unroll
                    for (int bj = 0; bj < 2; ++bj) { const u32x4 ww = w[ai][m][bj]; f32x4 o[2];
                        const f32x4 b0 = (f32x4){__builtin_bit_cast(float, ww.x << 16), __builtin_bit_cast(float, ww.x & 0xffff0000u), __builtin_bit_cast(float, ww.y << 16), __builtin_bit_cast(float, ww.y & 0xffff0000u)};
                        const f32x4 b1 = (f32x4){__builtin_bit_cast(float, ww.z << 16), __builtin_bit_cast(float, ww.z & 0xffff0000u), __builtin_bit_cast(float, ww.w << 16), __builtin_bit_cast(float, ww.w & 0xffff0000u)};
#pragma unroll
                        for (int n = 0; n < 2; ++n) { o[n] = (n ? b1 : b0) + acc[ai][bj][m][n];
                            sq += (o[n][0] * o[n][0] + o[n][1] * o[n][1]) + (o[n][2] * o[n][2] + o[n][3] * o[n][3]); }
                        if (out) { *(f32x4*)(out + off + bj * HALF) = o[0]; *(f32x4*)(out + off + bj * HALF + 4) = o[1]; }
                        else { u32x4 r; r.x = cvt_pk_bf16(o[0][0], o[0][1]); r.y = cvt_pk_bf16(o[0][2], o[0][3]); r.z = cvt_pk_bf16(o[1][0], o[1][1]); r.w = cvt_pk_bf16(o[1][2], o[1][3]); *(u32x4*)(xb + off + bj * HALF) = r; } }
                    if (ss) { sq += __shfl_xor(sq, 16); sq += __shfl_xor(sq, 32); if (fq == 0) atomicAdd(ss + row, ss_fix(sq)); } }
        }
    }
};

template <class Epi, class Sched>
__device__ __forceinline__ void gemm_phase(PG8_LAS unsigned char* lds, const Gemm g, const Sched& S, const Epi& E) {
    const int tid = tid_l(), wid = __builtin_amdgcn_readfirstlane(tid >> 6), lane = tid & 63, wr = wid >> 2, wc = wid & 3, fr = lane & 15, fq = lane >> 4;
    const int K = g.K, nt = K / BK;
    unsigned voffA[2], voffB[2];
#pragma unroll
    for (int i = 0; i < 2; ++i) { int R, C; stage_rc(tid * 16 + i * 8192, R, C); const int Rb = Epi::PERM ? ((R & ~31) + perm32(R & 31)) : R;
        voffA[i] = (unsigned)(R * g.lda + C) * 2u; voffB[i] = (unsigned)(Rb * g.ldb + C) * 2u; }
    const size_t kstep = (size_t)(BK * 2);
    const size_t hstepA = (size_t)HALF * g.lda * 2, hstepB = (size_t)HALF * g.ldb * 2;
    const size_t tstepA = 2 * hstepA, tstepB = 2 * hstepB, pnstepA = (size_t)g.a_pn_cols * 2;
    const unsigned ldsw = (unsigned)wid * 1024u;
    const int aoff = lds_byte(wr * 64 + fr, fq * 8), boff = lds_byte(wc * 32 + fr, fq * 8);
#define PG8_SA(b, h) (((b) * 2 + (h)) * HTB)
#define PG8_SB(b, h) ((4 + (b) * 2 + (h)) * HTB)
#define PG8_STAGE(bufoff, gbase, voff) do { _Pragma("unroll") for (int _i = 0; _i < 2; ++_i) \
        __builtin_amdgcn_global_load_lds((const unsigned*)((const char*)(gbase) + (voff)[_i]), (PG8_LAS unsigned*)(lds + (bufoff) + ldsw + _i * 8192), 16, 0, 0); } while (0)
#define PG8_LDA(dst, b, h) do { _Pragma("unroll") for (int m = 0; m < 4; ++m) _Pragma("unroll") for (int k = 0; k < 2; ++k) dst[m][k] = *(const PG8_LAS bf16x8*)(lds + PG8_SA(b, h) + aoff + m * 2048 + k * 1024); } while (0)
#define PG8_LDB(dst, b, h) do { _Pragma("unroll") for (int n = 0; n < 2; ++n) _Pragma("unroll") for (int k = 0; k < 2; ++k) dst[n][k] = *(const PG8_LAS bf16x8*)(lds + PG8_SB(b, h) + boff + n * 2048 + k * 1024); } while (0)
#define PG8_MMA(ai, bj, At, Bt) do { __builtin_amdgcn_s_setprio(1); _Pragma("unroll") for (int m = 0; m < 4; ++m) _Pragma("unroll") for (int n = 0; n < 2; ++n) _Pragma("unroll") for (int k = 0; k < 2; ++k) \
        acc[ai][bj][m][n] = __builtin_amdgcn_mfma_f32_16x16x32_bf16(Bt[n][k], At[m][k], acc[ai][bj][m][n], 0, 0, 0); __builtin_amdgcn_s_setprio(0); } while (0)
#define PG8_WAIT_V(n) asm volatile("s_waitcnt vmcnt(" #n ")" ::: "memory")
#define PG8_WAIT_L(n) asm volatile("s_waitcnt lgkmcnt(" #n ")" ::: "memory")
#define PG8_BAR __builtin_amdgcn_s_barrier()
#define PG8_SCHED __builtin_amdgcn_sched_barrier(0)
    Unit cur, nxt; int ui = 0;
    if (!S.next(0, cur)) return;
    f32x4 acc[2][2][4][2];
#pragma unroll
    for (int a = 0; a < 2; ++a)
#pragma unroll
        for (int b = 0; b < 2; ++b)
#pragma unroll
            for (int m = 0; m < 4; ++m)
#pragma unroll
                for (int n = 0; n < 2; ++n) acc[a][b][m][n] = (f32x4){0.f, 0.f, 0.f, 0.f};
    bf16x8 At[4][2], B0[2][2], B1[2][2];
    const char* cA = (const char*)g.A + (size_t)cur.pm * tstepA + (size_t)cur.pn * pnstepA; const char* cB = (const char*)g.Bt + (size_t)cur.pn * tstepB;
    PG8_STAGE(PG8_SB(0, 0), cB, voffB); PG8_STAGE(PG8_SB(0, 1), cB + hstepB, voffB); PG8_STAGE(PG8_SA(0, 0), cA, voffA); PG8_STAGE(PG8_SA(0, 1), cA + hstepA, voffA);
    if (wr == 1) PG8_BAR;
    PG8_WAIT_V(2); PG8_BAR;
    PG8_STAGE(PG8_SB(1, 0), cB + kstep, voffB); PG8_STAGE(PG8_SA(1, 0), cA + kstep, voffA); PG8_STAGE(PG8_SB(1, 1), cB + hstepB + kstep, voffB);
    PG8_WAIT_V(6); PG8_BAR;
    for (;;) {
        const bool has_next = S.next(ui + 1, nxt);
        const char* nA = has_next ? (const char*)g.A + (size_t)nxt.pm * tstepA + (size_t)nxt.pn * pnstepA : cA; const char* nB = has_next ? (const char*)g.Bt + (size_t)nxt.pn * tstepB : cB;
        for (int t = 0; t < nt; t += 2) {
            const bool last = (t == nt - 2);
            const char* a1 = cA + (size_t)(t + 1) * kstep;
            const char* a2 = last ? nA : cA + (size_t)(t + 2) * kstep; const char* b2 = last ? nB : cB + (size_t)(t + 2) * kstep;
            const char* a3 = a2 + kstep; const char* b3 = b2 + kstep;
            PG8_LDB(B0, 0, 0); PG8_LDB(B1, 0, 1); PG8_SCHED; PG8_LDA(At, 0, 0); PG8_STAGE(PG8_SA(1, 1), a1 + hstepA, voffA);
            PG8_WAIT_V(8); PG8_WAIT_L(0); PG8_BAR; PG8_MMA(0, 0, At, B0); PG8_MMA(0, 1, At, B1); PG8_BAR; PG8_SCHED;
            PG8_LDA(At, 0, 1); PG8_STAGE(PG8_SB(0, 0), b2, voffB); PG8_STAGE(PG8_SB(0, 1), b2 + hstepB, voffB); PG8_STAGE(PG8_SA(0, 0), a2, voffA);
            PG8_WAIT_V(8); PG8_WAIT_L(0); PG8_BAR; PG8_MMA(1, 0, At, B0); PG8_MMA(1, 1, At, B1); PG8_BAR; PG8_SCHED;
            PG8_LDB(B0, 1, 0); PG8_LDB(B1, 1, 1); PG8_SCHED; PG8_LDA(At, 1, 0); PG8_STAGE(PG8_SA(0, 1), a2 + hstepA, voffA);
            PG8_WAIT_V(8); PG8_WAIT_L(0); PG8_BAR; PG8_MMA(0, 0, At, B0); PG8_MMA(0, 1, At, B1); PG8_BAR; PG8_SCHED;
            PG8_LDA(At, 1, 1); PG8_STAGE(PG8_SB(1, 0), b3, voffB); PG8_STAGE(PG8_SB(1, 1), b3 + hstepB, voffB); PG8_STAGE(PG8_SA(1, 0), a3, voffA);
            PG8_WAIT_V(8); PG8_WAIT_L(0); PG8_BAR; PG8_MMA(1, 0, At, B0); PG8_MMA(1, 1, At, B1); PG8_BAR; PG8_SCHED;
        }
        if (wr == 0) PG8_BAR;
        E(acc, cur, wr, wc, fr, fq);
        if (!has_next) break;
#pragma unroll
        for (int a = 0; a < 2; ++a)
#pragma unroll
            for (int b = 0; b < 2; ++b)
#pragma unroll
                for (int m = 0; m < 4; ++m)
#pragma unroll
                    for (int n = 0; n < 2; ++n) acc[a][b][m][n] = (f32x4){0.f, 0.f, 0.f, 0.f};
        cur = nxt; cA = nA; cB = nB; ++ui;
        if (wr == 1) PG8_BAR;
    }
    PG8_WAIT_V(0);
    PG8_BAR;
#undef PG8_SA
#undef PG8_SB
#undef PG8_STAGE
#undef PG8_LDA
#undef PG8_LDB
#undef PG8_MMA
#undef PG8_WAIT_V
#undef PG8_WAIT_L
#undef PG8_BAR
#undef PG8_SCHED
}
}

namespace attn {
using bf16 = __hip_bfloat16;
constexpr int D = 128, NW = 8, QBLK = 32, KVBLK = 64;
constexpr float SCALE = 0.088388347648318440f;
constexpr float QSCALE = SCALE * 1.4426950408889634f;
constexpr float THR = 8.f;
constexpr int SDEPTH = 2;
constexpr int LDQ = DM, LDK = HD, LDO = DM;
constexpr size_t SHM_V = KVBLK * D * 2, SHM_K = KVBLK * D * 2, SHM_ATTN = 2 * SHM_V + 2 * SHM_K + NW * 64 * 4;
using bf16x8 = __attribute__((ext_vector_type(8))) short;
using s16x4  = __attribute__((ext_vector_type(4))) short;
using f32x16 = __attribute__((ext_vector_type(16))) float;
using u32x4  = __attribute__((ext_vector_type(4))) unsigned;
#define KSWZ(row, colB) ((row) * 256 + ((colB) ^ (((row) & 7) << 4)))
#define SBAR() __builtin_amdgcn_sched_barrier(0)
__device__ __forceinline__ int crow(int r, int hi) { return (r & 3) + 8 * (r >> 2) + 4 * hi; }
__device__ __forceinline__ unsigned cvtpk(float lo, float hi) { unsigned r; asm volatile("v_cvt_pk_bf16_f32 %0, %1, %2" : "=v"(r) : "v"(lo), "v"(hi)); return r; }
__device__ __forceinline__ bf16x8 ld8(const bf16* p) { return *reinterpret_cast<const bf16x8*>(p); }

__device__ __forceinline__ void partialSM(f32x16& p0, f32x16& p1, float& m_reg, float& mn, float& alpha) {
  float pmax = p0[0]; for (int r = 1; r < 16; ++r) pmax = fmaxf(pmax, p0[r]); for (int r = 0; r < 16; ++r) pmax = fmaxf(pmax, p1[r]);
  { auto rr = __builtin_amdgcn_permlane32_swap(__float_as_uint(pmax), __float_as_uint(pmax), false, false);
    pmax = fmaxf(__uint_as_float(rr[0]), __uint_as_float(rr[1])); }
  if (__builtin_expect(__all(pmax - m_reg <= THR * 1.4426950408889634f), 1)) { mn = m_reg; alpha = 1.f; }
  else { mn = fmaxf(m_reg, pmax); alpha = __builtin_amdgcn_exp2f(m_reg - mn); m_reg = mn; }
  for (int r = 0; r < 16; ++r) p0[r] = p0[r] - mn; for (int r = 0; r < 16; ++r) p1[r] = p1[r] - mn;
  for (int r = 0; r < 16; ++r) p0[r] = __builtin_amdgcn_exp2f(p0[r]);
}
__device__ __forceinline__ void finishSM(f32x16& p0, f32x16& p1, float alpha, float& l_reg, bf16x8& pa0, bf16x8& pa1, bf16x8& pa2, bf16x8& pa3) {
  for (int r = 0; r < 16; ++r) p1[r] = __builtin_amdgcn_exp2f(p1[r]);
  float ps = 0; for (int r = 0; r < 16; ++r) ps += p0[r]; for (int r = 0; r < 16; ++r) ps += p1[r];
  { auto rr = __builtin_amdgcn_permlane32_swap(__float_as_uint(ps), __float_as_uint(ps), false, false);
    ps = __uint_as_float(rr[0]) + __uint_as_float(rr[1]); }
  l_reg = l_reg * alpha + ps;
#define PK4(P, BASE, OUT) do { unsigned a0 = cvtpk(P[BASE + 0], P[BASE + 1]), a1 = cvtpk(P[BASE + 2], P[BASE + 3]);   \
    unsigned b0 = cvtpk(P[BASE + 4], P[BASE + 5]), b1 = cvtpk(P[BASE + 6], P[BASE + 7]);                              \
    auto r0 = __builtin_amdgcn_permlane32_swap(a0, b0, false, false); auto r1 = __builtin_amdgcn_permlane32_swap(a1, b1, false, false); \
    u32x4 w = {r0[0], r1[0], r0[1], r1[1]}; OUT = *reinterpret_cast<bf16x8*>(&w); } while (0)
  PK4(p0, 0, pa0); PK4(p0, 8, pa1); PK4(p1, 0, pa2); PK4(p1, 8, pa3);
#undef PK4
}
__device__ __forceinline__ void partialSM_b(f32x16& p0, f32x16& p1) {
  for (int r = 0; r < 16; ++r) p0[r] = __builtin_amdgcn_exp2f(p0[r]);
}
__device__ __forceinline__ void qkt(f32x16& p0, f32x16& p1, const bf16* Ks, const bf16x8* qr, int r32, int hi) {
  p0 = f32x16{}; p1 = f32x16{};
  for (int d0 = 0; d0 < 8; ++d0) { int cb = (d0 * 16 + hi * 8) * 2;
    bf16x8 b0 = *reinterpret_cast<const bf16x8*>((const char*)Ks + KSWZ(r32, cb));
    bf16x8 b1 = *reinterpret_cast<const bf16x8*>((const char*)Ks + KSWZ(32 + r32, cb));
    p0 = __builtin_amdgcn_mfma_f32_32x32x16_bf16(b0, qr[d0], p0, 0, 0, 0);
    p1 = __builtin_amdgcn_mfma_f32_32x32x16_bf16(b1, qr[d0], p1, 0, 0, 0); }
}
__device__ __forceinline__ int v_st(int k, int c) { const int kk = (k & ~0xC) | ((k & 4) << 1) | ((k & 8) >> 1); return ((kk >> 3) * 4 + (c >> 5)) * 512 + ((kk & 7) * 32 + (c & 31)) * 2; }
__device__ __forceinline__ int v_rd_base(int lane) { return ((lane & 3) << 3) | (((lane >> 2) & 3) << 6) | (((lane >> 4) & 1) << 5) | (((lane >> 5) & 1) << 8); }
constexpr int v_rd_off(int d0, int ks, int half) { return d0 * 512 + ks * 4096 + half * 2048; }
template <int OFF> __device__ __forceinline__ s16x4 tr_read(int vb) {
  s16x4 r; asm volatile("ds_read_b64_tr_b16 %0, %1 offset:%2" : "=&v"(r) : "v"(vb), "i"(OFF) : "memory"); return r;
}
template <int D0> __device__ __forceinline__ void pv_one(f32x16& od, int vb, bf16x8 pa0, bf16x8 pa1, bf16x8 pa2, bf16x8 pa3) {
  const s16x4 l0 = tr_read<v_rd_off(D0, 0, 0)>(vb), h0 = tr_read<v_rd_off(D0, 0, 1)>(vb), l1 = tr_read<v_rd_off(D0, 1, 0)>(vb), h1 = tr_read<v_rd_off(D0, 1, 1)>(vb);
  const s16x4 l2 = tr_read<v_rd_off(D0, 2, 0)>(vb), h2 = tr_read<v_rd_off(D0, 2, 1)>(vb), l3 = tr_read<v_rd_off(D0, 3, 0)>(vb), h3 = tr_read<v_rd_off(D0, 3, 1)>(vb);
  asm volatile("s_waitcnt lgkmcnt(0)" ::: "memory"); SBAR();
#define PK(L, H) (bf16x8){L[0], L[1], L[2], L[3], H[0], H[1], H[2], H[3]}
  od = __builtin_amdgcn_mfma_f32_32x32x16_bf16(pa0, PK(l0, h0), od, 0, 0, 0);
  od = __builtin_amdgcn_mfma_f32_32x32x16_bf16(pa1, PK(l1, h1), od, 0, 0, 0);
  od = __builtin_amdgcn_mfma_f32_32x32x16_bf16(pa2, PK(l2, h2), od, 0, 0, 0);
  od = __builtin_amdgcn_mfma_f32_32x32x16_bf16(pa3, PK(l3, h3), od, 0, 0, 0);
#undef PK
}
__device__ __forceinline__ void pv_d0(f32x16* o, int vb, bf16x8 pa0, bf16x8 pa1, bf16x8 pa2, bf16x8 pa3) {
  pv_one<0>(o[0], vb, pa0, pa1, pa2, pa3); pv_one<1>(o[1], vb, pa0, pa1, pa2, pa3); pv_one<2>(o[2], vb, pa0, pa1, pa2, pa3); pv_one<3>(o[3], vb, pa0, pa1, pa2, pa3);
}

template <bool BOUNDED>
__device__ __forceinline__ void attn_dense_body(const bf16* __restrict__ Qb, const bf16* __restrict__ Kh, const bf16* __restrict__ Vh,
                                                unsigned short* __restrict__ Ob, int seq, char* lds) {
  const int tid = tid_l(), wid = tid >> 6, lane = tid & 63, r32 = lane & 31, hi = lane >> 5;
  bf16* V_lds = (bf16*)lds; bf16* K_lds = (bf16*)(lds + 2 * SHM_V);
  float* ws = (float*)(lds + 2 * SHM_V + 2 * SHM_K) + wid * 64; float* li_l = ws; float* al_l = ws + 32;
  float m_reg = -1e30f, l_reg = 0; f32x16 o[4] = {}; bf16x8 qr[8];
  const bf16* Qw = Qb + (long)(wid * QBLK + r32) * LDQ + hi * 8;
#pragma unroll
  for (int d0 = 0; d0 < 8; ++d0) qr[d0] = ld8(Qw + d0 * 16);
  const int sr = tid >> 4, sc = (tid & 15) * 8, vst0 = v_st(sr, sc), vst1 = v_st(32 + sr, sc);
  const int vb0 = (int)(uintptr_t)V_lds + v_rd_base(lane);
  struct { bf16x8 vs0, vs1, ks0, ks1; } sr_[SDEPTH];
  const unsigned vo0 = (unsigned)(sr * LDK + sc) * 2u, vo1 = vo0 + 32u * LDK * 2u;
#define SLOAD(i, k0) do { const char* kb_ = (const char*)Kh + (size_t)(k0) * (LDK * 2); const char* vb_ = (const char*)Vh + (size_t)(k0) * (LDK * 2); \
    sr_[i].vs0 = *(const bf16x8*)(vb_ + vo0); sr_[i].vs1 = *(const bf16x8*)(vb_ + vo1); sr_[i].ks0 = *(const bf16x8*)(kb_ + vo0); sr_[i].ks1 = *(const bf16x8*)(kb_ + vo1); } while (0)
#define SWRITE(b, i) do { *(bf16x8*)((char*)V_lds + (b) * SHM_V + vst0) = sr_[i].vs0;          \
    *(bf16x8*)((char*)V_lds + (b) * SHM_V + vst1) = sr_[i].vs1; int kc = sc * 2;               \
    *(bf16x8*)((char*)K_lds + (b) * SHM_K + KSWZ(sr, kc)) = sr_[i].ks0;                       \
    *(bf16x8*)((char*)K_lds + (b) * SHM_K + KSWZ(32 + sr, kc)) = sr_[i].ks1; } while (0)
#define SWAIT() do { asm volatile("s_waitcnt vmcnt(4)" ::: "memory"); } while (0)
#define RESC(a) do { if (__any((a) < 1.f)) { if (hi == 0) al_l[r32] = (a); asm volatile("s_waitcnt lgkmcnt(0)" ::: "memory"); \
    for (int d = 0; d < 4; ++d) for (int r = 0; r < 16; ++r) o[d][r] *= al_l[crow(r, hi)]; } } while (0)
#define PSM(P0, P1, MN, AL) do { if constexpr (BOUNDED) { partialSM_b(P0, P1); AL = 1.f; } else partialSM(P0, P1, m_reg, MN, AL); } while (0)
  f32x16 pA0, pA1, pB0, pB1; float mnA = 0.f, mnB = 0.f, alA = 1.f, alB = 1.f; bf16x8 pa0, pa1, pa2, pa3; int NT = seq / KVBLK; asm volatile("" : "+s"(NT));
  constexpr int SE = 0, SO = SDEPTH - 1;
  SLOAD(SE, 0); SLOAD(SO, KVBLK);
  SWAIT(); SWRITE(0, SE); __syncthreads();
  SLOAD(SE, 2 * KVBLK);
  qkt(pA0, pA1, K_lds, qr, r32, hi); PSM(pA0, pA1, mnA, alA);
  SWAIT(); SWRITE(1, SO); __syncthreads();
  for (int j = 1; j + 1 < NT; j += 2) {
    SBAR(); qkt(pB0, pB1, (bf16*)((char*)K_lds + SHM_K), qr, r32, hi);
    finishSM(pA0, pA1, alA, l_reg, pa0, pa1, pa2, pa3); SBAR();
    SLOAD(SO, (j + SDEPTH) * KVBLK); SBAR();
    pv_d0(o, vb0, pa0, pa1, pa2, pa3); PSM(pB0, pB1, mnB, alB);
    __syncthreads(); SWAIT(); SWRITE(0, SE);
    if constexpr (!BOUNDED) RESC(alB); __syncthreads();
    SBAR(); qkt(pA0, pA1, K_lds, qr, r32, hi);
    finishSM(pB0, pB1, alB, l_reg, pa0, pa1, pa2, pa3); SBAR();
    SLOAD(SE, ((j + 3 < NT) ? (j + 1 + SDEPTH) : (NT - 1)) * KVBLK); SBAR();
    pv_d0(o, vb0 + (int)SHM_V, pa0, pa1, pa2, pa3); PSM(pA0, pA1, mnA, alA);
    __syncthreads(); SWAIT(); SWRITE(1, SO);
    if constexpr (!BOUNDED) RESC(alA); __syncthreads();
  }
  SBAR(); qkt(pB0, pB1, (bf16*)((char*)K_lds + SHM_K), qr, r32, hi);
  finishSM(pA0, pA1, alA, l_reg, pa0, pa1, pa2, pa3); SBAR();
  pv_d0(o, vb0, pa0, pa1, pa2, pa3); PSM(pB0, pB1, mnB, alB);
  __syncthreads(); if constexpr (!BOUNDED) RESC(alB);
  finishSM(pB0, pB1, alB, l_reg, pa0, pa1, pa2, pa3); SBAR();
  pv_d0(o, vb0 + (int)SHM_V, pa0, pa1, pa2, pa3);
  if (hi == 0) li_l[r32] = l_reg; asm volatile("s_waitcnt lgkmcnt(0)" ::: "memory");
  float rli[16];
#pragma unroll
  for (int r = 0; r < 16; ++r) rli[r] = __builtin_amdgcn_rcpf(li_l[crow(r, hi)]);
  unsigned short* Ow = Ob + (long)(wid * QBLK) * LDO;
  const int odd = lane & 1;
#pragma unroll
  for (int r = 0; r < 16; r += 2) { const int orow = crow(r + odd, hi);
#pragma unroll
    for (int d0 = 0; d0 < 4; ++d0) { const float a = o[d0][r] * rli[r], b = o[d0][r + 1] * rli[r + 1];
      const float send = odd ? a : b; const float recv = __shfl_xor(send, 1);
      const unsigned w = odd ? cvtpk(recv, b) : cvtpk(a, recv);
      *(unsigned*)(Ow + (long)orow * LDO + d0 * 32 + (r32 & ~1)) = w; } }
  __syncthreads();
#undef SLOAD
#undef SWRITE
#undef SWAIT
#undef RESC
#undef PSM
}
#undef KSWZ
#undef SBAR
}

#define LAS __attribute__((address_space(3)))
typedef unsigned short bf16;
typedef unsigned v4u __attribute__((ext_vector_type(4)));
typedef unsigned v2u __attribute__((ext_vector_type(2)));
typedef float f32x4 __attribute__((ext_vector_type(4)));
#define LDS_WAIT() asm volatile("s_waitcnt lgkmcnt(0)" ::: "memory")
__device__ __forceinline__ unsigned f2bf(float f) { unsigned u = __builtin_bit_cast(unsigned, f); return (u + 0x7fffu + ((u >> 16) & 1u)) >> 16; }
__device__ __forceinline__ unsigned pk2(float lo, float hi) { return f2bf(lo) | (f2bf(hi) << 16); }
__device__ __forceinline__ float bf_lo(unsigned w) { return __builtin_bit_cast(float, w << 16); }
__device__ __forceinline__ float bf_hi(unsigned w) { return __builtin_bit_cast(float, w & 0xffff0000u); }
__device__ __forceinline__ float wave_sum(float v) {
#pragma unroll
    for (int o = 1; o < 64; o <<= 1) v += __shfl_xor(v, o);
    return v;
}

struct Args { const float* in[13]; float* out; unsigned char* ws; int ph_lo, ph_hi; };
typedef const Args __attribute__((address_space(4)))* KArgs;

__device__ __forceinline__ int map_src_col(int mode, int n) {
    if (mode == 1) { const int pn = n >> 8, w = n & 255; return w < 128 ? pn * 128 + w : DFF + pn * 128 + (w - 128); }
    if (mode == 2) { if (n >= 1280) return n; const int h = n >> 7, d = n & 127, half = d >> 6, dd = d & 63; return h * 128 + half * 64 + (dd >> 1) + 32 * (dd & 1); }
    return n;
}
__device__ __forceinline__ void transpose_item(const float* W, int K, int N, bf16* WT, const float* gain, int mode, LAS float* scr, int item, int lane) {
    const int nblk = N / 32, kb = item / nblk, nb = item % nblk, k0 = 64 * kb, n0 = 32 * nb;
    const int srcc = map_src_col(mode, n0 + (lane & 31));
    float wv[32];
#pragma unroll
    for (int i = 0; i < 32; ++i) wv[i] = W[(size_t)(k0 + 2 * i + (lane >> 5)) * N + srcc];
#pragma unroll
    for (int i = 0; i < 32; ++i) { const int kk = 2 * i + (lane >> 5); float v = wv[i]; if (gain) v *= gain[k0 + kk]; scr[kk * 33 + (lane & 31)] = v; }
    LDS_WAIT(); asm volatile("" ::: "memory");
    const int c = lane & 7;
#pragma unroll
    for (int j = 0; j < 4; ++j) { const int n = (lane >> 3) + 8 * j; const LAS float* s = scr + (8 * c) * 33 + n;
        v4u o; o.x = pk2(s[0 * 33], s[1 * 33]); o.y = pk2(s[2 * 33], s[3 * 33]); o.z = pk2(s[4 * 33], s[5 * 33]); o.w = pk2(s[6 * 33], s[7 * 33]);
        *(v4u*)(WT + (size_t)(n0 + n) * K + k0 + 8 * c) = o; }
    LDS_WAIT(); asm volatile("" ::: "memory");
}

__device__ __forceinline__ void p0_prologue(KArgs a, LAS unsigned char* lds, int gw, int NGW, int wave, int lane) {
    unsigned char* ws = a->ws;
    LAS float* scr = (LAS float*)(lds + wave * 16384);
    const float* norm_mix = a->in[2]; const float* norm_ffn = a->in[3]; const float* pool_w = a->in[4];
    const float* w_qkv = a->in[7]; const float* w_o = a->in[10]; const float* w_gu = a->in[11]; const float* w_d = a->in[12];
    const float* x0 = a->in[0]; const float* x1 = a->in[1];
    constexpr int I_GU = (DM / 64) * (NGU / 32), I_D = (DFF / 64) * (DM / 32), I_QKV = (DM / 64) * (NQKV / 32), I_O = (DM / 64) * (DM / 32), I_P = (256 / 64) * (256 / 32);
    constexpr int NITEMS = 4 * I_GU + 4 * I_D + 2 * I_QKV + 2 * I_O + 8 * I_P;
    for (int it = gw; it < NITEMS; it += NGW) {
        int r = it;
        if (r < 4 * I_GU) { const int l = r / I_GU; r -= l * I_GU; transpose_item(w_gu + (size_t)l * DM * NGU, DM, NGU, (bf16*)(ws + WS_WGU) + (size_t)l * NGU * DM, norm_ffn + l * DM, 1, scr, r, lane); continue; } r -= 4 * I_GU;
        if (r < 4 * I_D) { const int l = r / I_D; r -= l * I_D; transpose_item(w_d + (size_t)l * DFF * DM, DFF, DM, (bf16*)(ws + WS_WD) + (size_t)l * DM * DFF, nullptr, 0, scr, r, lane); continue; } r -= 4 * I_D;
        if (r < 2 * I_QKV) { const int l = r / I_QKV; r -= l * I_QKV; transpose_item(w_qkv + (size_t)l * DM * NQKV, DM, NQKV, (bf16*)(ws + WS_WQKV) + (size_t)l * NQKV * DM, norm_mix + (2 * l + 1) * DM, 2, scr, r, lane); continue; } r -= 2 * I_QKV;
        if (r < 2 * I_O) { const int l = r / I_O; r -= l * I_O; transpose_item(w_o + (size_t)l * DM * DM, DM, DM, (bf16*)(ws + WS_WO) + (size_t)l * DM * DM, nullptr, 0, scr, r, lane); continue; } r -= 2 * I_O;
        { const int l = r / I_P; r -= l * I_P; transpose_item(pool_w + (size_t)l * 256 * 256, 256, 256, (bf16*)(ws + WS_WP) + (size_t)l * 256 * 256, nullptr, 0, scr, r, lane); }
    }
    for (int e = gw * 64 + lane; e < 64 * 32; e += NGW * 64) { const int pos = e >> 5, i = e & 31;
        const float inv = exp2f(-(float)(2 * i) * (1.0f / 64.0f) * 13.287712379549449f);
        const float ang = (float)pos * inv; float rev = ang * 0.15915494309189535f; rev -= floorf(rev);
        float2 cs; cs.x = __builtin_amdgcn_cosf(rev); cs.y = __builtin_amdgcn_sinf(rev);
        ((float2*)(ws + WS_ROPE))[e] = cs; }
    if (gw < 2) { const float* qg = a->in[8] + gw * HD; const float* kg = a->in[9] + gw * HD;
        float mq = fmaxf(fabsf(qg[lane]), fabsf(qg[lane + 64])), mk = fmaxf(fabsf(kg[lane]), fabsf(kg[lane + 64]));
#pragma unroll
        for (int o = 1; o < 64; o <<= 1) { mq = fmaxf(mq, __shfl_xor(mq, o)); mk = fmaxf(mk, __shfl_xor(mk, o)); }
        if (lane == 0) ((float*)(ws + WS_BOUND))[gw] = 11.313708498984761f * mq * mk * 1.02f; }
    { pg8::ss_t* ss = (pg8::ss_t*)(ws + WS_SS); for (size_t e = (size_t)gw * 64 + lane + M_TOT; e < (size_t)8 * M_TOT; e += (size_t)NGW * 64) ss[e] = 0ull; }
    { pg8::ss_t* ss = (pg8::ss_t*)(ws + WS_SS);
      for (int m = gw; m < M_TOT; m += 2 * NGW) { const int m2 = m + NGW;
          const bool has2 = m2 < M_TOT; const int mb = has2 ? m2 : m;
          const float* xa = (m < 4 * SEQ) ? x0 + (size_t)m * DM : x1 + (size_t)(m - 4 * SEQ) * DM; const float* xb_ = (mb < 4 * SEQ) ? x0 + (size_t)mb * DM : x1 + (size_t)(mb - 4 * SEQ) * DM;
          const f32x4* a4 = (const f32x4*)xa + lane; const f32x4* b4 = (const f32x4*)xb_ + lane; f32x4 va[4], vb[4];
#pragma unroll
          for (int j = 0; j < 4; ++j) { va[j] = a4[64 * j]; vb[j] = b4[64 * j]; }
          float sa = 0.f, sb = 0.f;
#pragma unroll
          for (int j = 0; j < 4; ++j) { sa += (va[j].x * va[j].x + va[j].y * va[j].y) + (va[j].z * va[j].z + va[j].w * va[j].w); sb += (vb[j].x * vb[j].x + vb[j].y * vb[j].y) + (vb[j].z * vb[j].z + vb[j].w * vb[j].w); }
          sa = wave_sum(sa); sb = wave_sum(sb); if (lane == 0) { ss[m] = pg8::ss_fix(sa); if (has2) ss[m2] = pg8::ss_fix(sb); } } }
}

template <bool F32IN, int GI>
__device__ __forceinline__ void pool_item(const float* xf, const bf16* xb, const pg8::ss_t* ss, const float* g, bf16* P, int t0, int lane) {
    constexpr int HW = 1 << GI, W = 2 * HW, NR = 15 + W, ELT = F32IN ? 4 : 2;
    const int bstart = t0 & ~(SEQ - 1), c = GI * 256 + lane * 4;
    float myrs; { const int myrow = t0 - HW + lane, myrc = min(max(myrow, bstart), bstart + SEQ - 1);
        myrs = (myrow == myrc) ? pg8::ss_rsqrt(ss, myrc) : 0.f; }
    f32x4 r[NR];
    int rc = max(t0 - HW, bstart);
    const char* p = (const char*)(F32IN ? (const void*)xf : (const void*)xb) + ((size_t)rc * DM + c) * ELT;
#pragma unroll
    for (int k = 0; k < NR; ++k) {
        if (F32IN) r[k] = *(const f32x4*)p;
        else { const v2u w = *(const v2u*)p; r[k] = (f32x4){bf_lo(w.x), bf_hi(w.x), bf_lo(w.y), bf_hi(w.y)}; }
        const int rcn = min(max(t0 - HW + k + 1, bstart), bstart + SEQ - 1);
        p += (size_t)(rcn - rc) * (DM * ELT); rc = rcn; asm volatile("" : "+v"(p)); }
    const f32x4 g4 = *(const f32x4*)(g + c);
#pragma unroll
    for (int k = 0; k < NR; ++k) r[k] = r[k] * __builtin_bit_cast(float, __builtin_amdgcn_readlane(__builtin_bit_cast(int, myrs), k));
    f32x4 S = r[0];
#pragma unroll
    for (int k = 1; k < W; ++k) S += r[k];
    bf16* q = P + (size_t)t0 * DM + c;
#pragma unroll
    for (int tt = 0; tt < 16; ++tt) { const int tl = t0 + tt - bstart; const int cnt = min(tl + HW, SEQ) - max(tl - HW, 0);
        const f32x4 p4 = (S * (1.0f / (float)cnt) - r[tt + HW]) * g4;
        v2u w; w.x = pk2(p4.x, p4.y); w.y = pk2(p4.z, p4.w);
        *(v2u*)q = w; q += DM; asm volatile("" : "+v"(q));
        if (tt < 15) S += r[tt + W] - r[tt]; }
}
template <bool F32IN, int GI>
__device__ __forceinline__ void pool_loop(const float* x0, const float* x1, const bf16* xb, const pg8::ss_t* ss, const float* g, bf16* P, int gw, int NGW, int lane) {
    const int nitems = (M_TOT / 16) * 4;
    for (int it = gw; it < nitems; it += NGW) { const int t0 = (it >> 2) * 16;
        const float* xf = F32IN ? ((t0 < 4 * SEQ) ? x0 : x1 - (size_t)4 * SEQ * DM) : nullptr;
        pool_item<F32IN, GI>(xf, xb, ss, g, P, t0, lane); }
}
template <bool F32IN>
__device__ __forceinline__ void pool_prep(const float* x0, const float* x1, const bf16* xb, const pg8::ss_t* ss, const float* g, bf16* P, int gw, int NGW, int lane) {
    const int gi = gw & 3;
    if (gi == 0) pool_loop<F32IN, 0>(x0, x1, xb, ss, g, P, gw, NGW, lane);
    else if (gi == 1) pool_loop<F32IN, 1>(x0, x1, xb, ss, g, P, gw, NGW, lane);
    else if (gi == 2) pool_loop<F32IN, 2>(x0, x1, xb, ss, g, P, gw, NGW, lane);
    else pool_loop<F32IN, 3>(x0, x1, xb, ss, g, P, gw, NGW, lane);
}

#define XB_TMO      128
#define XB_XCNT(j)  (256  + 64 * (j))
#define XB_XSUB(j)  (1280 + 64 * (j))
#define XB_XGEN(j)  (2304 + 64 * (j))
#define XB_TOP      3328
#define XB_TOPGEN   3392
#define XCD_BAR_WORDS 3456
#define XB_SPIN_CAP (1u << 18)
__device__ __forceinline__ unsigned xb_ld(unsigned* p)              { return __hip_atomic_load(p, __ATOMIC_RELAXED, __HIP_MEMORY_SCOPE_AGENT); }
__device__ __forceinline__ unsigned xb_add(unsigned* p, unsigned v) { return __hip_atomic_fetch_add(p, v, __ATOMIC_RELAXED, __HIP_MEMORY_SCOPE_AGENT); }
__device__ __forceinline__ unsigned xb_xcc_id() { return (unsigned)__builtin_amdgcn_s_getreg((3 << 11) | 20) & 0xFu; }
#define XB_SPIN(cond, bar) do { unsigned _sp = 0; while (cond) { __builtin_amdgcn_s_sleep(1); \
    if ((++_sp & 255u) == 0u) { if (xb_ld(&(bar)[XB_TMO])) break; if (_sp > XB_SPIN_CAP) { atomicAdd(&(bar)[XB_TMO], 1u); break; } } } } while (0)
__device__ __forceinline__ void xcd_barrier_complete(unsigned* bar, unsigned x, unsigned& nloc, unsigned& nx) {
    const unsigned G = gridDim.x * gridDim.y * gridDim.z;
    unsigned sum, cnt, mine, sp = 0u;
    for (;;) {
        sum = 0u; cnt = 0u; mine = 0u;
#pragma unroll
        for (unsigned j = 0; j < 16; ++j) { const unsigned c = xb_ld(&bar[XB_XCNT(j)]); sum += c; cnt += (c > 0u) ? 1u : 0u; mine = (j == x) ? c : mine; }
        if (sum == G) break;
        __builtin_amdgcn_s_sleep(1);
        if ((++sp & 255u) == 0u) { if (xb_ld(&bar[XB_TMO])) break; if (sp > XB_SPIN_CAP) { atomicAdd(&bar[XB_TMO], 1u); break; } }
    }
    nloc = mine > 0u ? mine : 1u; nx = cnt > 0u ? cnt : 1u;
}
__device__ __forceinline__ void xcd_barrier(unsigned* bar, volatile LAS unsigned* st) {
    asm volatile("s_waitcnt vmcnt(0)" ::: "memory");
    __syncthreads();
    if (threadIdx.x == 0) {
        const unsigned x = xb_xcc_id();
        __builtin_amdgcn_s_waitcnt(0);
        unsigned nloc = st[0], nx = st[1];
        if (nloc == 0u) { xcd_barrier_complete(bar, x, nloc, nx); st[0] = nloc; st[1] = nx; }
        const unsigned old = xb_add(&bar[XB_XSUB(x)], 1u);
        const unsigned gen = old / nloc;
        if (old + 1u == (gen + 1u) * nloc) {
            __builtin_amdgcn_fence(__ATOMIC_RELEASE, "agent");
            asm volatile("s_waitcnt vmcnt(0)" ::: "memory");
            const unsigned og = xb_add(&bar[XB_TOP], 1u);
            const unsigned tg = og / nx;
            if (og + 1u == (tg + 1u) * nx) xb_add(&bar[XB_TOPGEN], 1u);
            else XB_SPIN(xb_ld(&bar[XB_TOPGEN]) == tg, bar);
            __builtin_amdgcn_fence(__ATOMIC_ACQUIRE, "agent");
            xb_add(&bar[XB_XGEN(x)], 1u);
            asm volatile("s_waitcnt vmcnt(0)" ::: "memory");
        } else {
            XB_SPIN(xb_ld(&bar[XB_XGEN(x)]) == gen, bar);
            __builtin_amdgcn_fence(__ATOMIC_ACQUIRE, "agent");
            asm volatile("s_waitcnt vmcnt(0)" ::: "memory");
        }
    }
    __syncthreads();
}

__device__ __forceinline__ KArgs kargs() { KArgs p = (KArgs)__builtin_amdgcn_kernarg_segment_ptr(); asm volatile("" : "+s"(p)); return p; }
struct Ctx { int G, bx, vcu, gw, NGW, wave, lane; };
__device__ __forceinline__ Ctx ctx() { Ctx c; const int tid = tid_l(); c.lane = tid & 63; c.wave = __builtin_amdgcn_readfirstlane(tid >> 6); c.G = gridDim.x; c.bx = blockIdx.x;
    c.vcu = (c.G % 8 == 0) ? (c.bx % 8) * (c.G / 8) + c.bx / 8 : c.bx;
    c.gw = c.vcu * NWAVES + c.wave; c.NGW = c.G * NWAVES; return c; }

__device__ __forceinline__ void ph_prologue(LAS unsigned char* L) { KArgs ka = kargs(); const Ctx c = ctx(); p0_prologue(ka, L, c.gw, c.NGW, c.wave, c.lane); }
__device__ __forceinline__ void ph_pool_prep(int layer) { KArgs ka = kargs(); const Ctx c = ctx(); unsigned char* ws = ka->ws;
    const pg8::ss_t* ss_mix = (const pg8::ss_t*)(ws + WS_SS) + (size_t)(2 * layer) * M_TOT;
    if (layer == 0) pool_prep<true>(ka->in[0], ka->in[1], (const bf16*)(ws + WS_XB), ss_mix, ka->in[2] + layer * DM, (bf16*)(ws + WS_P), c.gw, c.NGW, c.lane);
    else pool_prep<false>(nullptr, nullptr, (const bf16*)(ws + WS_XB), ss_mix, ka->in[2] + layer * DM, (bf16*)(ws + WS_P), c.gw, c.NGW, c.lane); }
__device__ __forceinline__ void ph_qkv(LAS unsigned char* L, int layer) { KArgs ka = kargs(); const Ctx c = ctx(); unsigned char* ws = ka->ws; const int j = layer >> 1;
    pg8::Gemm g{(const bf16*)(ws + WS_XB), (const bf16*)(ws + WS_WQKV) + (size_t)j * NQKV * DM, M_TOT, NQKV, DM, DM, DM, 0}; pg8::StaticOrder S; S.init(M_TOT, NQKV, c.G, c.bx);
    pg8::EpiQKV E{(bf16*)(ws + WS_QKV), (bf16*)(ws + WS_KC), (bf16*)(ws + WS_VC), (const pg8::ss_t*)(ws + WS_SS) + (size_t)(2 * layer) * M_TOT, ka->in[8] + j * HD, ka->in[9] + j * HD, (const LAS float*)(L + 131072 + 10240), (LAS float*)(L + 131072 + 1024)};
    { const int tid = tid_l(); const v4u* src = (const v4u*)(ws + WS_ROPE); LAS v4u* dst = (LAS v4u*)(L + 131072 + 10240);
      dst[tid] = src[tid]; dst[tid + 512] = src[tid + 512]; LDS_WAIT(); }
    pg8::gemm_phase<pg8::EpiQKV, pg8::StaticOrder>(L, g, S, E);
}
__device__ __forceinline__ void ph_attn(unsigned char* lds, int layer) { KArgs ka = kargs(); const Ctx c = ctx(); unsigned char* ws = ka->ws;
    const float bound = ((const float*)(ws + WS_BOUND))[layer >> 1]; const bool bounded = bound < 40.f;
    bf16* QB = (bf16*)(ws + WS_QKV); bf16* KC = (bf16*)(ws + WS_KC); bf16* VC = (bf16*)(ws + WS_VC); bf16* OB = (bf16*)(ws + WS_O);
    for (int U = c.vcu; U < NB_TOT * 2 * 64; U += c.G) {
        int grp, uu;
        if (c.G == 256) { const int i = U >> 8, xcd = c.vcu >> 5, loc = c.vcu & 31; grp = xcd + 8 * (i >> 1); uu = (i & 1) * 32 + loc; }
        else { grp = U >> 6; uu = U & 63; }
        const int b = grp >> 1, kvh = grp & 1, head = kvh * 4 + (uu >> 4), qb = uu & 15;
        const size_t rowb = (size_t)b * SEQ, row0 = rowb + (size_t)qb * 256;
        if (bounded) attn::attn_dense_body<true>((const attn::bf16*)(QB + row0 * DM + head * HD), (const attn::bf16*)(KC + (size_t)grp * SEQ * HD),
                              (const attn::bf16*)(VC + (size_t)grp * SEQ * HD), OB + row0 * DM + head * HD, SEQ, (char*)lds);
        else attn::attn_dense_body<false>((const attn::bf16*)(QB + row0 * DM + head * HD), (const attn::bf16*)(KC + (size_t)grp * SEQ * HD),
                              (const attn::bf16*)(VC + (size_t)grp * SEQ * HD), OB + row0 * DM + head * HD, SEQ, (char*)lds);
    } }
__device__ __forceinline__ void ph_mix(LAS unsigned char* L, int layer) { KArgs ka = kargs(); const Ctx c = ctx(); unsigned char* ws = ka->ws; const int j = layer >> 1;
    pg8::Gemm g; const float* mbias = nullptr; const float* mscale = nullptr;
    if ((layer & 1) == 0) { g = pg8::Gemm{(const bf16*)(ws + WS_P), (const bf16*)(ws + WS_WP) + (size_t)j * DM * 256, M_TOT, DM, 256, DM, 256, 256}; mbias = ka->in[5] + j * DM; mscale = ka->in[6] + j * DM; }
    else g = pg8::Gemm{(const bf16*)(ws + WS_O), (const bf16*)(ws + WS_WO) + (size_t)j * DM * DM, M_TOT, DM, DM, DM, DM, 0};
    pg8::StaticOrder S; S.init(M_TOT, DM, c.G, c.bx);
    const float* b_lo = (layer == 0) ? ka->in[0] : nullptr; const float* b_hi = (layer == 0) ? ka->in[1] - (size_t)4 * SEQ * DM : nullptr;
    pg8::EpiRes E{b_lo, b_hi, 4 * SEQ / 256, nullptr, (bf16*)(ws + WS_XB), (pg8::ss_t*)(ws + WS_SS) + (size_t)(2 * layer + 1) * M_TOT, mbias, mscale};
    pg8::gemm_phase<pg8::EpiRes, pg8::StaticOrder>(L, g, S, E);
}
__device__ __forceinline__ void ph_gateup(LAS unsigned char* L, int layer) { KArgs ka = kargs(); const Ctx c = ctx(); unsigned char* ws = ka->ws;
    pg8::Gemm g{(const bf16*)(ws + WS_XB), (const bf16*)(ws + WS_WGU) + (size_t)layer * NGU * DM, M_TOT, NGU, DM, DM, DM, 0}; pg8::StaticOrder S; S.init(M_TOT, NGU, c.G, c.bx);
    pg8::EpiSwiGLU E{(bf16*)(ws + WS_H), (const pg8::ss_t*)(ws + WS_SS) + (size_t)(2 * layer + 1) * M_TOT};
    pg8::gemm_phase<pg8::EpiSwiGLU, pg8::StaticOrder>(L, g, S, E);
}
__device__ __forceinline__ void ph_down(LAS unsigned char* L, int layer) { KArgs ka = kargs(); const Ctx c = ctx(); unsigned char* ws = ka->ws;
    pg8::Gemm g{(const bf16*)(ws + WS_H), (const bf16*)(ws + WS_WD) + (size_t)layer * DM * DFF, M_TOT, DM, DFF, DFF, DFF, 0}; pg8::StaticOrder S; S.init(M_TOT, DM, c.G, c.bx);
    pg8::EpiRes E{nullptr, nullptr, 0, (layer < 3) ? nullptr : ka->out, (bf16*)(ws + WS_XB), (layer < 3) ? (pg8::ss_t*)(ws + WS_SS) + (size_t)(2 * layer + 2) * M_TOT : nullptr, nullptr, nullptr};
    pg8::gemm_phase<pg8::EpiRes, pg8::StaticOrder>(L, g, S, E);
}

__global__ void __launch_bounds__(NWAVES * 64, 2) mk_fwd(Args args) {
    extern __shared__ __attribute__((aligned(16))) unsigned char lds[];
    cg::grid_group grid = cg::this_grid();
    LAS unsigned char* L = (LAS unsigned char*)lds;
    const int lo = args.ph_lo, hi = args.ph_hi;
    if (threadIdx.x < 2) ((volatile LAS unsigned*)(L + 131072 + 256))[threadIdx.x] = 0u;
    __syncthreads();
    if (MK_N_LAUNCHES == 1 && threadIdx.x == 0) (void)xb_add((unsigned*)(args.ws + WS_BAR) + XB_XCNT(xb_xcc_id()), 1u);
#define RUN(k) (lo <= (k) && (k) < hi)
#define SEAM(k) do { if (RUN(k) && RUN((k) + 1)) { KArgs ka_ = kargs(); xcd_barrier((unsigned*)(ka_->ws + WS_BAR), (volatile LAS unsigned*)(L + 131072 + 256)); } } while (0)
    int ph = 0;
    if (RUN(ph)) ph_prologue(L);
    if (args.ph_lo < -1) grid.sync();
    SEAM(ph);
    ++ph;
    for (int layer = 0; layer < 4; ++layer) {
        if ((layer & 1) == 0) {
            if (RUN(ph)) ph_pool_prep(layer);
            SEAM(ph); ++ph;
        } else {
            if (RUN(ph)) ph_qkv(L, layer);
            SEAM(ph); ++ph;
            if (RUN(ph)) ph_attn(lds, layer);
            SEAM(ph); ++ph;
        }
        if (RUN(ph)) ph_mix(L, layer);
        SEAM(ph); ++ph;
        if (RUN(ph)) ph_gateup(L, layer);
        SEAM(ph); ++ph;
        if (RUN(ph)) ph_down(L, layer);
        SEAM(ph); ++ph;
    }
#undef RUN
#undef SEAM
}

extern "C" void kernel_launch(void* const* d_in, const int* in_sizes, int n_in, void* d_out, int out_size, void* d_ws, size_t ws_size, hipStream_t stream) {
    static int grid = 0;
    if (grid == 0) {
        if (n_in != 13 || in_sizes[0] != 4 * SEQ * DM || in_sizes[1] != 8 * SEQ * DM || out_size != M_TOT * DM || ws_size < WS_END) {
            fprintf(stderr, "kernel_launch: shape mismatch n_in %d in0 %d in1 %d out %d ws %zu\n", n_in, n_in > 0 ? in_sizes[0] : -1, n_in > 1 ? in_sizes[1] : -1, out_size, ws_size); grid = -1; return; }
        int dev = 0, cus = 0, per_cu = 0;
        if (hipGetDevice(&dev) != hipSuccess || hipDeviceGetAttribute(&cus, hipDeviceAttributeMultiprocessorCount, dev) != hipSuccess) { grid = -1; return; }
        if (hipFuncSetAttribute((const void*)mk_fwd, hipFuncAttributeMaxDynamicSharedMemorySize, LDS_BYTES) != hipSuccess) { fprintf(stderr, "kernel_launch: hipFuncSetAttribute failed\n"); grid = -1; return; }
        if (hipOccupancyMaxActiveBlocksPerMultiprocessor(&per_cu, (const void*)mk_fwd, NWAVES * 64, LDS_BYTES) != hipSuccess || per_cu < 1) { fprintf(stderr, "kernel_launch: occupancy query says %d\n", per_cu); per_cu = 1; }
        (void)hipGetLastError();
        grid = cus * (per_cu > 1 ? 1 : per_cu);
    }
    if (grid < 0) return;
    if (hipMemsetAsync((char*)d_ws + WS_BAR, 0, 16384, stream) != hipSuccess) { fprintf(stderr, "kernel_launch: memset of the barrier words failed\n"); return; }
    Args a{};
    for (int i = 0; i < 13; ++i) a.in[i] = (const float*)d_in[i];
    a.out = (float*)d_out; a.ws = (unsigned char*)d_ws;
#if MK_N_LAUNCHES == 1
    a.ph_lo = 0; a.ph_hi = N_PHASES;
    void* kargs[] = {&a};
    hipError_t e = hipLaunchCooperativeKernel((const void*)mk_fwd, dim3(grid), dim3(NWAVES * 64), kargs, LDS_BYTES, stream);
    if (e != hipSuccess) fprintf(stderr, "kernel_launch: cooperative launch failed: %s (grid %d)\n", hipGetErrorString(e), grid);
#else
    for (int p = 0; p < N_PHASES; ++p) { a.ph_lo = p; a.ph_hi = p + 1;
        hipLaunchKernelGGL(mk_fwd, dim3(grid), dim3(NWAVES * 64), LDS_BYTES, stream, a);
        const hipError_t le = hipPeekAtLastError();
        if (le != hipSuccess) { fprintf(stderr, "kernel_launch: launch %d failed: %s\n", p, hipGetErrorName(le)); break; } }
#endif
}
```

```cpp
#include <hip/hip_runtime.h>
#include <hip/hip_bf16.h>
#include <hip/hip_cooperative_groups.h>
#include <cstdio>
#include <cstdint>
namespace cg = cooperative_groups;

#ifndef MK_N_LAUNCHES
#define MK_N_LAUNCHES 1
#endif

constexpr int DM = 1024, SEQ = 4096, NB_TOT = 12, M_TOT = NB_TOT * SEQ;
constexpr int DFF = 2816, NGU = 2 * DFF, NQKV = 1536, HD = 128;
constexpr float EPS = 1e-6f;
constexpr int N_PHASES = 19;

constexpr size_t MiB = 1u << 20;
constexpr size_t WS_ROPE = 0;
constexpr size_t WS_BOUND = 32768;
constexpr size_t WS_BAR = 2 * MiB - 65536;
constexpr size_t WS_WGU = 2 * MiB;
constexpr size_t WS_WD = 46 * MiB;
constexpr size_t WS_WQKV = 68 * MiB;
constexpr size_t WS_WO = 74 * MiB;
constexpr size_t WS_WP = 78 * MiB;
constexpr size_t WS_XB = 80 * MiB;
constexpr size_t WS_H = 176 * MiB;
constexpr size_t WS_QKV = 176 * MiB;
constexpr size_t WS_KC = 272 * MiB;
constexpr size_t WS_VC = 296 * MiB;
constexpr size_t WS_O = 320 * MiB;
constexpr size_t WS_P = 176 * MiB;
constexpr size_t WS_SS = 440 * MiB;
constexpr size_t WS_END = 444 * MiB;
static_assert(WS_ROPE + 64 * 32 * 8 <= WS_BAR && WS_BAR + 16384 <= WS_WGU && WS_WGU + (size_t)4 * NGU * DM * 2 <= WS_WD && WS_WD + (size_t)4 * DM * DFF * 2 <= WS_WQKV, "ws map 1");
static_assert(WS_WQKV + (size_t)2 * NQKV * DM * 2 <= WS_WO && WS_WO + (size_t)2 * DM * DM * 2 <= WS_WP && WS_WP + (size_t)2 * DM * 256 * 2 <= WS_XB, "ws map 2");
static_assert(WS_XB + (size_t)M_TOT * DM * 2 <= WS_H && WS_H + (size_t)M_TOT * DFF * 2 <= WS_SS && WS_SS + (size_t)8 * M_TOT * 8 <= WS_END && WS_QKV + (size_t)M_TOT * DM * 2 <= WS_KC && WS_KC + (size_t)M_TOT * 256 * 2 <= WS_VC && WS_VC + (size_t)M_TOT * 256 * 2 <= WS_O && WS_O + (size_t)M_TOT * DM * 2 <= WS_END, "ws map 3");

__device__ __forceinline__ int tid_l() { int t = threadIdx.x; asm volatile("" : "+v"(t)); return t; }
constexpr int LDS_BYTES = 131072 + 26624;
constexpr int NWAVES = 8;

namespace pg8 {
#define PG8_LAS __attribute__((address_space(3)))
typedef unsigned short bf16_t;
typedef short bf16x8 __attribute__((ext_vector_type(8)));
typedef float f32x4 __attribute__((ext_vector_type(4)));
typedef unsigned u32x4 __attribute__((ext_vector_type(4)));
typedef unsigned u32x2 __attribute__((ext_vector_type(2)));
constexpr int BM = 256, BK = 64, HALF = 128, HTB = HALF * BK * 2, STAGE_BYTES = 8 * HTB, NXCD = 8, WGM = 8;

__host__ __device__ __forceinline__ int lds_byte(int r, int c) { const int st = (r >> 4) * 2 + (c >> 5), rr = r & 15, cc = c & 31, ob = rr * 64 + cc * 2; return st * 1024 + (ob ^ (((ob >> 9) & 1) << 5)); }
__host__ __device__ __forceinline__ void stage_rc(int b, int& R, int& C) { const int st = b / 1024, sb = b % 1024, swz = sb ^ (((sb >> 9) & 1) << 5); R = (st >> 1) * 16 + swz / 64; C = (st & 1) * 32 + (swz % 64) / 2; }
__host__ __device__ __forceinline__ int perm32(int rho) { const int n = rho >> 4, i = rho & 15; return 8 * (i >> 2) + 4 * n + (i & 3); }

struct Unit { int pm, pn; };
struct Gemm { const bf16_t* A; const bf16_t* Bt; int M, N, K, lda, ldb, a_pn_cols; };

struct StaticOrder {
    int nM, nN, nwg, G, c;
    __host__ __device__ void init(int M, int N, int G_, int c_) { nM = M / BM; nN = N / BM; nwg = nM * nN; G = G_; c = c_; }
    __host__ __device__ bool next(int i, Unit& u) const {
        const long L = (long)i * G + c; if (L >= nwg) return false;
        int wgid = (int)L; { const int q = nwg / NXCD, r = nwg % NXCD, xcd = wgid % NXCD, off = wgid / NXCD; wgid = (xcd < r ? xcd * (q + 1) : r * (q + 1) + (xcd - r) * q) + off; }
        const int nig = WGM * nN, gid = wgid / nig, fm = gid * WGM, gsz = (nM - fm) < WGM ? (nM - fm) : WGM;
        u.pm = fm + ((wgid % nig) % gsz); u.pn = (wgid % nig) / gsz; return true;
    }
};

__device__ __forceinline__ unsigned cvt_pk_bf16(float lo, float hi) { unsigned r; asm("v_cvt_pk_bf16_f32 %0, %1, %2" : "=v"(r) : "v"(lo), "v"(hi)); return r; }
typedef unsigned long long ss_t;
__device__ __forceinline__ float ss_rsqrt(const ss_t* ss, int row) { return __builtin_amdgcn_rsqf((float)ss[row] * (1.0f / 16777216.0f / DM) + EPS); }
__device__ __forceinline__ ss_t ss_fix(float sq) { return (ss_t)(sq * 16777216.0f + 0.5f); }
__device__ __forceinline__ void ss_rsqrt8(const ss_t* ss, int row0, float (&r)[2][4]) {
    ss_t v[2][4];
#pragma unroll
    for (int ai = 0; ai < 2; ++ai)
#pragma unroll
        for (int m = 0; m < 4; ++m) v[ai][m] = ss[row0 + ai * HALF + m * 16];
#pragma unroll
    for (int ai = 0; ai < 2; ++ai)
#pragma unroll
        for (int m = 0; m < 4; ++m) r[ai][m] = __builtin_amdgcn_rsqf((float)v[ai][m] * (1.0f / 16777216.0f / DM) + EPS);
}


struct EpiQKV {
    static constexpr bool PERM = true;
    bf16_t* Q; bf16_t* Kc; bf16_t* Vc; const ss_t* ss; const float* q_gain; const float* k_gain; const PG8_LAS float* rope; PG8_LAS float* part;
    __device__ __forceinline__ static size_t kv_off(int row, int bj) { return ((size_t)((row >> 12) * 2 + bj) * SEQ + (row & (SEQ - 1))) * HD; }
    __device__ __forceinline__ void operator()(const f32x4 (&acc)[2][2][4][2], const Unit& u, int wr, int wc, int fr, int fq) const {
        const int row0 = u.pm * BM + wr * 64 + fr, col0 = u.pn * BM + wc * 32 + 8 * fq;
        if (u.pn >= 5) {
#pragma unroll
            for (int ai = 0; ai < 2; ++ai)
#pragma unroll
                for (int m = 0; m < 4; ++m) { const int row = row0 + ai * HALF + m * 16; const float r = ss_rsqrt(ss, row);
#pragma unroll
                    for (int bj = 0; bj < 2; ++bj) { const f32x4 v0 = acc[ai][bj][m][0] * r, v1 = acc[ai][bj][m][1] * r;
                        u32x4 w; w.x = cvt_pk_bf16(v0[0], v0[1]); w.y = cvt_pk_bf16(v0[2], v0[3]); w.z = cvt_pk_bf16(v1[0], v1[1]); w.w = cvt_pk_bf16(v1[2], v1[3]);
                        *(u32x4*)(Vc + kv_off(row, bj) + wc * 32 + 8 * fq) = w; } }
            return;
        }
        float rr[2][4];
#pragma unroll
        for (int ai = 0; ai < 2; ++ai)
#pragma unroll
            for (int m = 0; m < 4; ++m) { const int rl = ai * HALF + wr * 64 + m * 16 + fr; const float r = ss_rsqrt(ss, u.pm * BM + rl); rr[ai][m] = r;
#pragma unroll
                for (int bj = 0; bj < 2; ++bj) { const f32x4 a = acc[ai][bj][m][0], b = acc[ai][bj][m][1];
                    float sq = ((a[0] * a[0] + a[1] * a[1]) + (a[2] * a[2] + a[3] * a[3])) + ((b[0] * b[0] + b[1] * b[1]) + (b[2] * b[2] + b[3] * b[3]));
                    sq += __shfl_xor(sq, 16); sq += __shfl_xor(sq, 32);
                    if (fq == 0) part[(rl * 2 + bj) * 4 + wc] = sq * r * r; } }
        asm volatile("s_waitcnt lgkmcnt(0)" ::: "memory"); __builtin_amdgcn_s_barrier(); asm volatile("" ::: "memory");
        const int half = wc >> 1, ib = (wc & 1) * 16 + 4 * fq; const float qsc = (u.pn == 4) ? 1.0f : 0.12752041570284543f;
        const float* gn = (u.pn == 4 ? k_gain : q_gain) + half * 64 + ib;
        const f32x4 g1 = *(const f32x4*)gn, g2 = *(const f32x4*)(gn + 32);
#pragma unroll
        for (int ai = 0; ai < 2; ++ai)
#pragma unroll
            for (int m = 0; m < 4; ++m) { const int rl = ai * HALF + wr * 64 + m * 16 + fr, row = u.pm * BM + rl, t = row & (SEQ - 1), pos = half ? (t & 63) : (t >> 6);
                const f32x4 cs01 = *(const PG8_LAS f32x4*)(rope + (pos * 32 + ib) * 2), cs23 = *(const PG8_LAS f32x4*)(rope + (pos * 32 + ib) * 2 + 4);
#pragma unroll
                for (int bj = 0; bj < 2; ++bj) { const f32x4 p4 = *(const PG8_LAS f32x4*)(part + (rl * 2 + bj) * 4);
                    bf16_t* dst = (u.pn == 4) ? Kc + kv_off(row, bj) + wc * 32 + 8 * fq : Q + (size_t)row * DM + col0 + bj * HALF;
                    const float rn = __builtin_amdgcn_rsqf(((p4[0] + p4[1]) + (p4[2] + p4[3])) * (1.0f / HD) + EPS) * rr[ai][m] * qsc;
                    const f32x4 a = acc[ai][bj][m][0] * rn, b = acc[ai][bj][m][1] * rn;
                    const float x10 = a[0] * g1[0], x20 = a[1] * g2[0], x11 = a[2] * g1[1], x21 = a[3] * g2[1], x12 = b[0] * g1[2], x22 = b[1] * g2[2], x13 = b[2] * g1[3], x23 = b[3] * g2[3];
                    u32x4 w;
                    w.x = cvt_pk_bf16(x10 * cs01[0] - x20 * cs01[1], x20 * cs01[0] + x10 * cs01[1]);
                    w.y = cvt_pk_bf16(x11 * cs01[2] - x21 * cs01[3], x21 * cs01[2] + x11 * cs01[3]);
                    w.z = cvt_pk_bf16(x12 * cs23[0] - x22 * cs23[1], x22 * cs23[0] + x12 * cs23[1]);
                    w.w = cvt_pk_bf16(x13 * cs23[2] - x23 * cs23[3], x23 * cs23[2] + x13 * cs23[3]);
                    *(u32x4*)dst = w; } }
    }
};
struct EpiSwiGLU {
    static constexpr bool PERM = true;
    bf16_t* H; const ss_t* ss;
    __device__ __forceinline__ void operator()(const f32x4 (&acc)[2][2][4][2], const Unit& u, int wr, int wc, int fr, int fq) const {
        const int row0 = u.pm * BM + wr * 64 + fr, col0 = u.pn * HALF + wc * 32 + 8 * fq;
        float rr[2][4]; ss_rsqrt8(ss, row0, rr);
#pragma unroll
        for (int ai = 0; ai < 2; ++ai)
#pragma unroll
            for (int m = 0; m < 4; ++m) { const int row = row0 + ai * HALF + m * 16; const float r = rr[ai][m];
                typedef float f32x2 __attribute__((ext_vector_type(2)));
                const float rn = r * -1.4426950408889634f, r2 = r * r;
                unsigned hw[4];
#pragma unroll
                for (int n = 0; n < 2; ++n)
#pragma unroll
                    for (int jp = 0; jp < 2; ++jp) { const f32x2 g = {acc[ai][0][m][n][2 * jp], acc[ai][0][m][n][2 * jp + 1]}, uu = {acc[ai][1][m][n][2 * jp], acc[ai][1][m][n][2 * jp + 1]};
                        const f32x2 t = g * rn; f32x2 e; e.x = __builtin_amdgcn_exp2f(t.x); e.y = __builtin_amdgcn_exp2f(t.y);
                        const f32x2 d = e + 1.0f; f32x2 rc; rc.x = __builtin_amdgcn_rcpf(d.x); rc.y = __builtin_amdgcn_rcpf(d.y);
                        const f32x2 h = (g * uu) * (rc * r2);
                        hw[n * 2 + jp] = cvt_pk_bf16(h.x, h.y); }
                u32x4 w; w.x = hw[0]; w.y = hw[1]; w.z = hw[2]; w.w = hw[3];
                *(u32x4*)(H + (size_t)row * DFF + col0) = w; }
    }
};
struct EpiRes {
    static constexpr bool PERM = true;
    const float* xin_lo; const float* xin_hi; int split_pm; float* out; bf16_t* xb; ss_t* ss; const float* bias; const float* scale;
    template <bool F32, int NM>
    __device__ __forceinline__ void rows(const f32x4 (&acc)[2][2][4][2], const float* xin, int ai, int m0, int row0, int col0, int fq, const f32x4 (&bv)[2][2], const f32x4 (&sv)[2][2]) const {
        const size_t off0 = (size_t)(row0 + ai * HALF + m0 * 16) * DM + col0;
        f32x4 b[NM][2][2];
        if (F32) {
#pragma unroll
            for (int m = 0; m < NM; ++m)
#pragma unroll
                for (int bj = 0; bj < 2; ++bj)
#pragma unroll
                    for (int n = 0; n < 2; ++n) b[m][bj][n] = *(const f32x4*)(xin + off0 + (size_t)m * 16 * DM + bj * HALF + 4 * n);
        } else {
            u32x4 w[NM][2];
#pragma unroll
            for (int m = 0; m < NM; ++m)
#pragma unroll
                for (int bj = 0; bj < 2; ++bj) w[m][bj] = *(const u32x4*)(xb + off0 + (size_t)m * 16 * DM + bj * HALF);
#pragma unroll
            for (int m = 0; m < NM; ++m)
#pragma unroll
                for (int bj = 0; bj < 2; ++bj) {
                    b[m][bj][0] = (f32x4){__builtin_bit_cast(float, w[m][bj].x << 16), __builtin_bit_cast(float, w[m][bj].x & 0xffff0000u), __builtin_bit_cast(float, w[m][bj].y << 16), __builtin_bit_cast(float, w[m][bj].y & 0xffff0000u)};
                    b[m][bj][1] = (f32x4){__builtin_bit_cast(float, w[m][bj].z << 16), __builtin_bit_cast(float, w[m][bj].z & 0xffff0000u), __builtin_bit_cast(float, w[m][bj].w << 16), __builtin_bit_cast(float, w[m][bj].w & 0xffff0000u)}; }
        }
#pragma unroll
        for (int m = 0; m < NM; ++m) { const int row = row0 + ai * HALF + (m0 + m) * 16; const size_t off = off0 + (size_t)m * 16 * DM; float sq = 0.f;
#pragma unroll
            for (int bj = 0; bj < 2; ++bj) { f32x4 o[2];
#pragma unroll
                for (int n = 0; n < 2; ++n) { f32x4 v = acc[ai][bj][m0 + m][n];
                    if (bias) v = (v + bv[bj][n]) * sv[bj][n];
                    o[n] = b[m][bj][n] + v;
                    sq += (o[n][0] * o[n][0] + o[n][1] * o[n][1]) + (o[n][2] * o[n][2] + o[n][3] * o[n][3]); }
                if (out) { *(f32x4*)(out + off + bj * HALF) = o[0]; *(f32x4*)(out + off + bj * HALF + 4) = o[1]; }
                else { u32x4 w; w.x = cvt_pk_bf16(o[0][0], o[0][1]); w.y = cvt_pk_bf16(o[0][2], o[0][3]); w.z = cvt_pk_bf16(o[1][0], o[1][1]); w.w = cvt_pk_bf16(o[1][2], o[1][3]); *(u32x4*)(xb + off + bj * HALF) = w; } }
            if (ss) { sq += __shfl_xor(sq, 16); sq += __shfl_xor(sq, 32); if (fq == 0) atomicAdd(ss + row, ss_fix(sq)); } }
        asm volatile("" ::: "memory");
    }
    __device__ __forceinline__ void operator()(const f32x4 (&acc)[2][2][4][2], const Unit& u, int wr, int wc, int fr, int fq) const {
        const int col0 = u.pn * BM + wc * 32 + 8 * fq, row0 = u.pm * BM + wr * 64 + fr;
        const float* xin = (u.pm < split_pm) ? xin_lo : xin_hi;
        f32x4 bv[2][2], sv[2][2];
#pragma unroll
        for (int bj = 0; bj < 2; ++bj)
#pragma unroll
            for (int n = 0; n < 2; ++n) { bv[bj][n] = bias ? *(const f32x4*)(bias + col0 + bj * HALF + 4 * n) : (f32x4){0.f, 0.f, 0.f, 0.f}; sv[bj][n] = bias ? *(const f32x4*)(scale + col0 + bj * HALF + 4 * n) : (f32x4){1.f, 1.f, 1.f, 1.f}; }
        if (xin) {
#pragma unroll
            for (int ai = 0; ai < 2; ++ai) { rows<true, 2>(acc, xin, ai, 0, row0, col0, fq, bv, sv); rows<true, 2>(acc, xin, ai, 2, row0, col0, fq, bv, sv); }
        } else if (bias) {
#pragma unroll
            for (int ai = 0; ai < 2; ++ai) rows<false, 4>(acc, xin, ai, 0, row0, col0, fq, bv, sv);
        } else {
            u32x4 w[2][4][2];
#pragma unroll
            for (int ai = 0; ai < 2; ++ai)
#pragma unroll
                for (int m = 0; m < 4; ++m)
#pragma unroll
                    for (int bj = 0; bj < 2; ++bj) w[ai][m][bj] = *(const u32x4*)(xb + (size_t)(row0 + ai * HALF + m * 16) * DM + col0 + bj * HALF);
#pragma unroll
            for (int ai = 0; ai < 2; ++ai)
#pragma unroll
                for (int m = 0; m < 4; ++m) { const int row = row0 + ai * HALF + m * 16; const size_t off = (size_t)row * DM + col0; float sq = 0.f;
#pragma unroll
                    for (int bj = 0; bj < 2; ++bj) { const u32x4 ww = w[ai][m][bj]; f32x4 o[2];
                        const f32x4 b0 = (f32x4){__builtin_bit_cast(float, ww.x << 16), __builtin_bit_cast(float, ww.x & 0xffff0000u), __builtin_bit_cast(float, ww.y << 16), __builtin_bit_cast(float, ww.y & 0xffff0000u)};
                        const f32x4 b1 = (f32x4){__builtin_bit_cast(float, ww.z << 16), __builtin_bit_cast(float, ww.z & 0xffff0000u), __builtin_bit_cast(float, ww.w << 16), __builtin_bit_cast(float, ww.w & 0xffff0000u)};
#pragma unroll
                        for (int n = 0; n < 2; ++n) { o[n] = (n ? b1 : b0) + acc[ai][bj][m][n];
                            sq += (o[n][0] * o[n][0] + o[n][1] * o[n][1]) + (o[n][2] * o[n][2] + o[n][3] * o[n][3]); }
                        if (out) { *(f32x4*)(out + off + bj * HALF) = o[0]; *(f32x4*)(out + off + bj * HALF + 4) = o[1]; }
                        else { u32x4 r; r.x = cvt_pk_bf16(o[0][0], o[0][1]); r.y = cvt_pk_bf16(o[0][2], o[0][3]); r.z = cvt_pk_bf16(o[1][0], o[1][1]); r.w = cvt_pk_bf16(o[1][2], o[1][3]); *(u32x4*)(xb + off + bj * HALF) = r; } }
                    if (ss) { sq += __shfl_xor(sq, 16); sq += __shfl_xor(sq, 32); if (fq == 0) atomicAdd(ss + row, ss_fix(sq)); } }
        }
    }
};

template <class Epi, class Sched>
__device__ __forceinline__ void gemm_phase(PG8_LAS unsigned char* lds, const Gemm g, const Sched& S, const Epi& E) {
    const int tid = tid_l(), wid = __builtin_amdgcn_readfirstlane(tid >> 6), lane = tid & 63, wr = wid >> 2, wc = wid & 3, fr = lane & 15, fq = lane >> 4;
    const int K = g.K, nt = K / BK;
    unsigned voffA[2], voffB[2];
#pragma unroll
    for (int i = 0; i < 2; ++i) { int R, C; stage_rc(tid * 16 + i * 8192, R, C); const int Rb = Epi::PERM ? ((R & ~31) + perm32(R & 31)) : R;
        voffA[i] = (unsigned)(R * g.lda + C) * 2u; voffB[i] = (unsigned)(Rb * g.ldb + C) * 2u; }
    const size_t kstep = (size_t)(BK * 2);
    const size_t hstepA = (size_t)HALF * g.lda * 2, hstepB = (size_t)HALF * g.ldb * 2;
    const size_t tstepA = 2 * hstepA, tstepB = 2 * hstepB, pnstepA = (size_t)g.a_pn_cols * 2;
    const unsigned ldsw = (unsigned)wid * 1024u;
    const int aoff = lds_byte(wr * 64 + fr, fq * 8), boff = lds_byte(wc * 32 + fr, fq * 8);
#define PG8_SA(b, h) (((b) * 2 + (h)) * HTB)
#define PG8_SB(b, h) ((4 + (b) * 2 + (h)) * HTB)
#define PG8_STAGE(bufoff, gbase, voff) do { _Pragma("unroll") for (int _i = 0; _i < 2; ++_i) \
        __builtin_amdgcn_global_load_lds((const unsigned*)((const char*)(gbase) + (voff)[_i]), (PG8_LAS unsigned*)(lds + (bufoff) + ldsw + _i * 8192), 16, 0, 0); } while (0)
#define PG8_LDA(dst, b, h) do { _Pragma("unroll") for (int m = 0; m < 4; ++m) _Pragma("unroll") for (int k = 0; k < 2; ++k) dst[m][k] = *(const PG8_LAS bf16x8*)(lds + PG8_SA(b, h) + aoff + m * 2048 + k * 1024); } while (0)
#define PG8_LDB(dst, b, h) do { _Pragma("unroll") for (int n = 0; n < 2; ++n) _Pragma("unroll") for (int k = 0; k < 2; ++k) dst[n][k] = *(const PG8_LAS bf16x8*)(lds + PG8_SB(b, h) + boff + n * 2048 + k * 1024); } while (0)
#define PG8_MMA(ai, bj, At, Bt) do { __builtin_amdgcn_s_setprio(1); _Pragma("unroll") for (int m = 0; m < 4; ++m) _Pragma("unroll") for (int n = 0; n < 2; ++n) _Pragma("unroll") for (int k = 0; k < 2; ++k) \
        acc[ai][bj][m][n] = __builtin_amdgcn_mfma_f32_16x16x32_bf16(Bt[n][k], At[m][k], acc[ai][bj][m][n], 0, 0, 0); __builtin_amdgcn_s_setprio(0); } while (0)
#define PG8_WAIT_V(n) asm volatile("s_waitcnt vmcnt(" #n ")" ::: "memory")
#define PG8_WAIT_L(n) asm volatile("s_waitcnt lgkmcnt(" #n ")" ::: "memory")
#define PG8_BAR __builtin_amdgcn_s_barrier()
#define PG8_SCHED __builtin_amdgcn_sched_barrier(0)
    Unit cur, nxt; int ui = 0;
    if (!S.next(0, cur)) return;
    f32x4 acc[2][2][4][2];
#pragma unroll
    for (int a = 0; a < 2; ++a)
#pragma unroll
        for (int b = 0; b < 2; ++b)
#pragma unroll
            for (int m = 0; m < 4; ++m)
#pragma unroll
                for (int n = 0; n < 2; ++n) acc[a][b][m][n] = (f32x4){0.f, 0.f, 0.f, 0.f};
    bf16x8 At[4][2], B0[2][2], B1[2][2];
    const char* cA = (const char*)g.A + (size_t)cur.pm * tstepA + (size_t)cur.pn * pnstepA; const char* cB = (const char*)g.Bt + (size_t)cur.pn * tstepB;
    PG8_STAGE(PG8_SB(0, 0), cB, voffB); PG8_STAGE(PG8_SB(0, 1), cB + hstepB, voffB); PG8_STAGE(PG8_SA(0, 0), cA, voffA); PG8_STAGE(PG8_SA(0, 1), cA + hstepA, voffA);
    if (wr == 1) PG8_BAR;
    PG8_WAIT_V(2); PG8_BAR;
    PG8_STAGE(PG8_SB(1, 0), cB + kstep, voffB); PG8_STAGE(PG8_SA(1, 0), cA + kstep, voffA); PG8_STAGE(PG8_SB(1, 1), cB + hstepB + kstep, voffB);
    PG8_WAIT_V(6); PG8_BAR;
    for (;;) {
        const bool has_next = S.next(ui + 1, nxt);
        const char* nA = has_next ? (const char*)g.A + (size_t)nxt.pm * tstepA + (size_t)nxt.pn * pnstepA : cA; const char* nB = has_next ? (const char*)g.Bt + (size_t)nxt.pn * tstepB : cB;
        for (int t = 0; t < nt; t += 2) {
            const bool last = (t == nt - 2);
            const char* a1 = cA + (size_t)(t + 1) * kstep;
            const char* a2 = last ? nA : cA + (size_t)(t + 2) * kstep; const char* b2 = last ? nB : cB + (size_t)(t + 2) * kstep;
            const char* a3 = a2 + kstep; const char* b3 = b2 + kstep;
            PG8_LDB(B0, 0, 0); PG8_LDB(B1, 0, 1); PG8_SCHED; PG8_LDA(At, 0, 0); PG8_STAGE(PG8_SA(1, 1), a1 + hstepA, voffA);
            PG8_WAIT_V(8); PG8_WAIT_L(0); PG8_BAR; PG8_MMA(0, 0, At, B0); PG8_MMA(0, 1, At, B1); PG8_BAR; PG8_SCHED;
            PG8_LDA(At, 0, 1); PG8_STAGE(PG8_SB(0, 0), b2, voffB); PG8_STAGE(PG8_SB(0, 1), b2 + hstepB, voffB); PG8_STAGE(PG8_SA(0, 0), a2, voffA);
            PG8_WAIT_V(8); PG8_WAIT_L(0); PG8_BAR; PG8_MMA(1, 0, At, B0); PG8_MMA(1, 1, At, B1); PG8_BAR; PG8_SCHED;
            PG8_LDB(B0, 1, 0); PG8_LDB(B1, 1, 1); PG8_SCHED; PG8_LDA(At, 1, 0); PG8_STAGE(PG8_SA(0, 1), a2 + hstepA, voffA);
            PG8_WAIT_V(8); PG8_WAIT_L(0); PG8_BAR; PG8_MMA(0, 0, At, B0); PG8_MMA(0, 1, At, B1); PG8_BAR; PG8_SCHED;
            PG8_LDA(At, 1, 1); PG8_STAGE(PG8_SB(1, 0), b3, voffB); PG8_STAGE(PG8_SB(1, 1), b3 + hstepB, voffB); PG8_STAGE(PG8_SA(1, 0), a3, voffA);
            PG8_WAIT_V(8); PG8_WAIT_L(0); PG8_BAR; PG8_MMA(1, 0, At, B0); PG8_MMA(1, 1, At, B1); PG8_BAR; PG8_SCHED;
        }
        if (wr == 0) PG8_BAR;
        E(acc, cur, wr, wc, fr, fq);
        if (!has_next) break;
#pragma unroll
        for (int a = 0; a < 2; ++a)
#pragma unroll
            for (int b = 0; b < 2; ++b)
#pragma unroll
                for (int m = 0; m < 4; ++m)
#pragma unroll
                    for (int n = 0; n < 2; ++n) acc[a][b][m][n] = (f32x4){0.f, 0.f, 0.f, 0.f};
        cur = nxt; cA = nA; cB = nB; ++ui;
        if (wr == 1) PG8_BAR;
    }
    PG8_WAIT_V(0);
    PG8_BAR;
#undef PG8_SA
#undef PG8_SB
#undef PG8_STAGE
#undef PG8_LDA
#undef PG8_LDB
#undef PG8_MMA
#undef PG8_WAIT_V
#undef PG8_WAIT_L
#undef PG8_BAR
#undef PG8_SCHED
}
}

namespace attn {
using bf16 = __hip_bfloat16;
constexpr int D = 128, NW = 8, QBLK = 32, KVBLK = 64;
constexpr float SCALE = 0.088388347648318440f;
constexpr float QSCALE = SCALE * 1.4426950408889634f;
constexpr float THR = 8.f;
constexpr int SDEPTH = 2;
constexpr int LDQ = DM, LDK = HD, LDO = DM;
constexpr size_t SHM_V = KVBLK * D * 2, SHM_K = KVBLK * D * 2, SHM_ATTN = 2 * SHM_V + 2 * SHM_K + NW * 64 * 4;
using bf16x8 = __attribute__((ext_vector_type(8))) short;
using s16x4  = __attribute__((ext_vector_type(4))) short;
using f32x16 = __attribute__((ext_vector_type(16))) float;
using u32x4  = __attribute__((ext_vector_type(4))) unsigned;
#define KSWZ(row, colB) ((row) * 256 + ((colB) ^ (((row) & 7) << 4)))
#define SBAR() __builtin_amdgcn_sched_barrier(0)
__device__ __forceinline__ int crow(int r, int hi) { return (r & 3) + 8 * (r >> 2) + 4 * hi; }
__device__ __forceinline__ unsigned cvtpk(float lo, float hi) { unsigned r; asm volatile("v_cvt_pk_bf16_f32 %0, %1, %2" : "=v"(r) : "v"(lo), "v"(hi)); return r; }
__device__ __forceinline__ bf16x8 ld8(const bf16* p) { return *reinterpret_cast<const bf16x8*>(p); }

__device__ __forceinline__ void partialSM(f32x16& p0, f32x16& p1, float& m_reg, float& mn, float& alpha) {
  float pmax = p0[0]; for (int r = 1; r < 16; ++r) pmax = fmaxf(pmax, p0[r]); for (int r = 0; r < 16; ++r) pmax = fmaxf(pmax, p1[r]);
  { auto rr = __builtin_amdgcn_permlane32_swap(__float_as_uint(pmax), __float_as_uint(pmax), false, false);
    pmax = fmaxf(__uint_as_float(rr[0]), __uint_as_float(rr[1])); }
  if (__builtin_expect(__all(pmax - m_reg <= THR * 1.4426950408889634f), 1)) { mn = m_reg; alpha = 1.f; }
  else { mn = fmaxf(m_reg, pmax); alpha = __builtin_amdgcn_exp2f(m_reg - mn); m_reg = mn; }
  for (int r = 0; r < 16; ++r) p0[r] = p0[r] - mn; for (int r = 0; r < 16; ++r) p1[r] = p1[r] - mn;
  for (int r = 0; r < 16; ++r) p0[r] = __builtin_amdgcn_exp2f(p0[r]);
}
__device__ __forceinline__ void finishSM(f32x16& p0, f32x16& p1, float alpha, float& l_reg, bf16x8& pa0, bf16x8& pa1, bf16x8& pa2, bf16x8& pa3) {
  for (int r = 0; r < 16; ++r) p1[r] = __builtin_amdgcn_exp2f(p1[r]);
  float ps = 0; for (int r = 0; r < 16; ++r) ps += p0[r]; for (int r = 0; r < 16; ++r) ps += p1[r];
  { auto rr = __builtin_amdgcn_permlane32_swap(__float_as_uint(ps), __float_as_uint(ps), false, false);
    ps = __uint_as_float(rr[0]) + __uint_as_float(rr[1]); }
  l_reg = l_reg * alpha + ps;
#define PK4(P, BASE, OUT) do { unsigned a0 = cvtpk(P[BASE + 0], P[BASE + 1]), a1 = cvtpk(P[BASE + 2], P[BASE + 3]);   \
    unsigned b0 = cvtpk(P[BASE + 4], P[BASE + 5]), b1 = cvtpk(P[BASE + 6], P[BASE + 7]);                              \
    auto r0 = __builtin_amdgcn_permlane32_swap(a0, b0, false, false); auto r1 = __builtin_amdgcn_permlane32_swap(a1, b1, false, false); \
    u32x4 w = {r0[0], r1[0], r0[1], r1[1]}; OUT = *reinterpret_cast<bf16x8*>(&w); } while (0)
  PK4(p0, 0, pa0); PK4(p0, 8, pa1); PK4(p1, 0, pa2); PK4(p1, 8, pa3);
#undef PK4
}
__device__ __forceinline__ void partialSM_b(f32x16& p0, f32x16& p1) {
  for (int r = 0; r < 16; ++r) p0[r] = __builtin_amdgcn_exp2f(p0[r]);
}
__device__ __forceinline__ void qkt(f32x16& p0, f32x16& p1, const bf16* Ks, const bf16x8* qr, int r32, int hi) {
  p0 = f32x16{}; p1 = f32x16{};
  for (int d0 = 0; d0 < 8; ++d0) { int cb = (d0 * 16 + hi * 8) * 2;
    bf16x8 b0 = *reinterpret_cast<const bf16x8*>((const char*)Ks + KSWZ(r32, cb));
    bf16x8 b1 = *reinterpret_cast<const bf16x8*>((const char*)Ks + KSWZ(32 + r32, cb));
    p0 = __builtin_amdgcn_mfma_f32_32x32x16_bf16(b0, qr[d0], p0, 0, 0, 0);
    p1 = __builtin_amdgcn_mfma_f32_32x32x16_bf16(b1, qr[d0], p1, 0, 0, 0); }
}
__device__ __forceinline__ int v_st(int k, int c) { const int kk = (k & ~0xC) | ((k & 4) << 1) | ((k & 8) >> 1); return ((kk >> 3) * 4 + (c >> 5)) * 512 + ((kk & 7) * 32 + (c & 31)) * 2; }
__device__ __forceinline__ int v_rd_base(int lane) { return ((lane & 3) << 3) | (((lane >> 2) & 3) << 6) | (((lane >> 4) & 1) << 5) | (((lane >> 5) & 1) << 8); }
constexpr int v_rd_off(int d0, int ks, int half) { return d0 * 512 + ks * 4096 + half * 2048; }
template <int OFF> __device__ __forceinline__ s16x4 tr_read(int vb) {
  s16x4 r; asm volatile("ds_read_b64_tr_b16 %0, %1 offset:%2" : "=&v"(r) : "v"(vb), "i"(OFF) : "memory"); return r;
}
template <int D0> __device__ __forceinline__ void pv_one(f32x16& od, int vb, bf16x8 pa0, bf16x8 pa1, bf16x8 pa2, bf16x8 pa3) {
  const s16x4 l0 = tr_read<v_rd_off(D0, 0, 0)>(vb), h0 = tr_read<v_rd_off(D0, 0, 1)>(vb), l1 = tr_read<v_rd_off(D0, 1, 0)>(vb), h1 = tr_read<v_rd_off(D0, 1, 1)>(vb);
  const s16x4 l2 = tr_read<v_rd_off(D0, 2, 0)>(vb), h2 = tr_read<v_rd_off(D0, 2, 1)>(vb), l3 = tr_read<v_rd_off(D0, 3, 0)>(vb), h3 = tr_read<v_rd_off(D0, 3, 1)>(vb);
  asm volatile("s_waitcnt lgkmcnt(0)" ::: "memory"); SBAR();
#define PK(L, H) (bf16x8){L[0], L[1], L[2], L[3], H[0], H[1], H[2], H[3]}
  od = __builtin_amdgcn_mfma_f32_32x32x16_bf16(pa0, PK(l0, h0), od, 0, 0, 0);
  od = __builtin_amdgcn_mfma_f32_32x32x16_bf16(pa1, PK(l1, h1), od, 0, 0, 0);
  od = __builtin_amdgcn_mfma_f32_32x32x16_bf16(pa2, PK(l2, h2), od, 0, 0, 0);
  od = __builtin_amdgcn_mfma_f32_32x32x16_bf16(pa3, PK(l3, h3), od, 0, 0, 0);
#undef PK
}
__device__ __forceinline__ void pv_d0(f32x16* o, int vb, bf16x8 pa0, bf16x8 pa1, bf16x8 pa2, bf16x8 pa3) {
  pv_one<0>(o[0], vb, pa0, pa1, pa2, pa3); pv_one<1>(o[1], vb, pa0, pa1, pa2, pa3); pv_one<2>(o[2], vb, pa0, pa1, pa2, pa3); pv_one<3>(o[3], vb, pa0, pa1, pa2, pa3);
}

template <bool BOUNDED>
__device__ __forceinline__ void attn_dense_body(const bf16* __restrict__ Qb, const bf16* __restrict__ Kh, const bf16* __restrict__ Vh,
                                                unsigned short* __restrict__ Ob, int seq, char* lds) {
  const int tid = tid_l(), wid = tid >> 6, lane = tid & 63, r32 = lane & 31, hi = lane >> 5;
  bf16* V_lds = (bf16*)lds; bf16* K_lds = (bf16*)(lds + 2 * SHM_V);
  float* ws = (float*)(lds + 2 * SHM_V + 2 * SHM_K) + wid * 64; float* li_l = ws; float* al_l = ws + 32;
  float m_reg = -1e30f, l_reg = 0; f32x16 o[4] = {}; bf16x8 qr[8];
  const bf16* Qw = Qb + (long)(wid * QBLK + r32) * LDQ + hi * 8;
#pragma unroll
  for (int d0 = 0; d0 < 8; ++d0) qr[d0] = ld8(Qw + d0 * 16);
  const int sr = tid >> 4, sc = (tid & 15) * 8, vst0 = v_st(sr, sc), vst1 = v_st(32 + sr, sc);
  const int vb0 = (int)(uintptr_t)V_lds + v_rd_base(lane);
  struct { bf16x8 vs0, vs1, ks0, ks1; } sr_[SDEPTH];
  const unsigned vo0 = (unsigned)(sr * LDK + sc) * 2u, vo1 = vo0 + 32u * LDK * 2u;
#define SLOAD(i, k0) do { const char* kb_ = (const char*)Kh + (size_t)(k0) * (LDK * 2); const char* vb_ = (const char*)Vh + (size_t)(k0) * (LDK * 2); \
    sr_[i].vs0 = *(const bf16x8*)(vb_ + vo0); sr_[i].vs1 = *(const bf16x8*)(vb_ + vo1); sr_[i].ks0 = *(const bf16x8*)(kb_ + vo0); sr_[i].ks1 = *(const bf16x8*)(kb_ + vo1); } while (0)
#define SWRITE(b, i) do { *(bf16x8*)((char*)V_lds + (b) * SHM_V + vst0) = sr_[i].vs0;          \
    *(bf16x8*)((char*)V_lds + (b) * SHM_V + vst1) = sr_[i].vs1; int kc = sc * 2;               \
    *(bf16x8*)((char*)K_lds + (b) * SHM_K + KSWZ(sr, kc)) = sr_[i].ks0;                       \
    *(bf16x8*)((char*)K_lds + (b) * SHM_K + KSWZ(32 + sr, kc)) = sr_[i].ks1; } while (0)
#define SWAIT() do { asm volatile("s_waitcnt vmcnt(4)" ::: "memory"); } while (0)
#define RESC(a) do { if (__any((a) < 1.f)) { if (hi == 0) al_l[r32] = (a); asm volatile("s_waitcnt lgkmcnt(0)" ::: "memory"); \
    for (int d = 0; d < 4; ++d) for (int r = 0; r < 16; ++r) o[d][r] *= al_l[crow(r, hi)]; } } while (0)
#define PSM(P0, P1, MN, AL) do { if constexpr (BOUNDED) { partialSM_b(P0, P1); AL = 1.f; } else partialSM(P0, P1, m_reg, MN, AL); } while (0)
  f32x16 pA0, pA1, pB0, pB1; float mnA = 0.f, mnB = 0.f, alA = 1.f, alB = 1.f; bf16x8 pa0, pa1, pa2, pa3; int NT = seq / KVBLK; asm volatile("" : "+s"(NT));
  constexpr int SE = 0, SO = SDEPTH - 1;
  SLOAD(SE, 0); SLOAD(SO, KVBLK);
  SWAIT(); SWRITE(0, SE); __syncthreads();
  SLOAD(SE, 2 * KVBLK);
  qkt(pA0, pA1, K_lds, qr, r32, hi); PSM(pA0, pA1, mnA, alA);
  SWAIT(); SWRITE(1, SO); __syncthreads();
  for (int j = 1; j + 1 < NT; j += 2) {
    SBAR(); qkt(pB0, pB1, (bf16*)((char*)K_lds + SHM_K), qr, r32, hi);
    finishSM(pA0, pA1, alA, l_reg, pa0, pa1, pa2, pa3); SBAR();
    SLOAD(SO, (j + SDEPTH) * KVBLK); SBAR();
    pv_d0(o, vb0, pa0, pa1, pa2, pa3); PSM(pB0, pB1, mnB, alB);
    __syncthreads(); SWAIT(); SWRITE(0, SE);
    if constexpr (!BOUNDED) RESC(alB); __syncthreads();
    SBAR(); qkt(pA0, pA1, K_lds, qr, r32, hi);
    finishSM(pB0, pB1, alB, l_reg, pa0, pa1, pa2, pa3); SBAR();
    SLOAD(SE, ((j + 3 < NT) ? (j + 1 + SDEPTH) : (NT - 1)) * KVBLK); SBAR();
    pv_d0(o, vb0 + (int)SHM_V, pa0, pa1, pa2, pa3); PSM(pA0, pA1, mnA, alA);
    __syncthreads(); SWAIT(); SWRITE(1, SO);
    if constexpr (!BOUNDED) RESC(alA); __syncthreads();
  }
  SBAR(); qkt(pB0, pB1, (bf16*)((char*)K_lds + SHM_K), qr, r32, hi);
  finishSM(pA0, pA1, alA, l_reg, pa0, pa1, pa2, pa3); SBAR();
  pv_d0(o, vb0, pa0, pa1, pa2, pa3); PSM(pB0, pB1, mnB, alB);
  __syncthreads(); if constexpr (!BOUNDED) RESC(alB);
  finishSM(pB0, pB1, alB, l_reg, pa0, pa1, pa2, pa3); SBAR();
  pv_d0(o, vb0 + (int)SHM_V, pa0, pa1, pa2, pa3);
  if (hi == 0) li_l[r32] = l_reg; asm volatile("s_waitcnt lgkmcnt(0)" ::: "memory");
  float rli[16];
#pragma unroll
  for (int r = 0; r < 16; ++r) rli[r] = __builtin_amdgcn_rcpf(li_l[crow(r, hi)]);
  unsigned short* Ow = Ob + (long)(wid * QBLK) * LDO;
  const int odd = lane & 1;
#pragma unroll
  for (int r = 0; r < 16; r += 2) { const int orow = crow(r + odd, hi);
#pragma unroll
    for (int d0 = 0; d0 < 4; ++d0) { const float a = o[d0][r] * rli[r], b = o[d0][r + 1] * rli[r + 1];
      const float send = odd ? a : b; const float recv = __shfl_xor(send, 1);
      const unsigned w = odd ? cvtpk(recv, b) : cvtpk(a, recv);
      *(unsigned*)(Ow + (long)orow * LDO + d0 * 32 + (r32 & ~1)) = w; } }
  __syncthreads();
#undef SLOAD
#undef SWRITE
#undef SWAIT
#undef RESC
#undef PSM
}
#undef KSWZ
#undef SBAR
}

#define LAS __attribute__((address_space(3)))
typedef unsigned short bf16;
typedef unsigned v4u __attribute__((ext_vector_type(4)));
typedef unsigned v2u __attribute__((ext_vector_type(2)));
typedef float f32x4 __attribute__((ext_vector_type(4)));
#define LDS_WAIT() asm volatile("s_waitcnt lgkmcnt(0)" ::: "memory")
__device__ __forceinline__ unsigned f2bf(float f) { unsigned u = __builtin_bit_cast(unsigned, f); return (u + 0x7fffu + ((u >> 16) & 1u)) >> 16; }
__device__ __forceinline__ unsigned pk2(float lo, float hi) { return f2bf(lo) | (f2bf(hi) << 16); }
__device__ __forceinline__ float bf_lo(unsigned w) { return __builtin_bit_cast(float, w << 16); }
__device__ __forceinline__ float bf_hi(unsigned w) { return __builtin_bit_cast(float, w & 0xffff0000u); }
__device__ __forceinline__ float wave_sum(float v) {
#pragma unroll
    for (int o = 1; o < 64; o <<= 1) v += __shfl_xor(v, o);
    return v;
}

struct Args { const float* in[13]; float* out; unsigned char* ws; int ph_lo, ph_hi; };
typedef const Args __attribute__((address_space(4)))* KArgs;

__device__ __forceinline__ int map_src_col(int mode, int n) {
    if (mode == 1) { const int pn = n >> 8, w = n & 255; return w < 128 ? pn * 128 + w : DFF + pn * 128 + (w - 128); }
    if (mode == 2) { if (n >= 1280) return n; const int h = n >> 7, d = n & 127, half = d >> 6, dd = d & 63; return h * 128 + half * 64 + (dd >> 1) + 32 * (dd & 1); }
    return n;
}
__device__ __forceinline__ void transpose_item(const float* W, int K, int N, bf16* WT, const float* gain, int mode, LAS float* scr, int item, int lane) {
    const int nblk = N / 32, kb = item / nblk, nb = item % nblk, k0 = 64 * kb, n0 = 32 * nb;
    const int srcc = map_src_col(mode, n0 + (lane & 31));
    float wv[32];
#pragma unroll
    for (int i = 0; i < 32; ++i) wv[i] = W[(size_t)(k0 + 2 * i + (lane >> 5)) * N + srcc];
#pragma unroll
    for (int i = 0; i < 32; ++i) { const int kk = 2 * i + (lane >> 5); float v = wv[i]; if (gain) v *= gain[k0 + kk]; scr[kk * 33 + (lane & 31)] = v; }
    LDS_WAIT(); asm volatile("" ::: "memory");
    const int c = lane & 7;
#pragma unroll
    for (int j = 0; j < 4; ++j) { const int n = (lane >> 3) + 8 * j; const LAS float* s = scr + (8 * c) * 33 + n;
        v4u o; o.x = pk2(s[0 * 33], s[1 * 33]); o.y = pk2(s[2 * 33], s[3 * 33]); o.z = pk2(s[4 * 33], s[5 * 33]); o.w = pk2(s[6 * 33], s[7 * 33]);
        *(v4u*)(WT + (size_t)(n0 + n) * K + k0 + 8 * c) = o; }
    LDS_WAIT(); asm volatile("" ::: "memory");
}

__device__ __forceinline__ void p0_prologue(KArgs a, LAS unsigned char* lds, int gw, int NGW, int wave, int lane) {
    unsigned char* ws = a->ws;
    LAS float* scr = (LAS float*)(lds + wave * 16384);
    const float* norm_mix = a->in[2]; const float* norm_ffn = a->in[3]; const float* pool_w = a->in[4];
    const float* w_qkv = a->in[7]; const float* w_o = a->in[10]; const float* w_gu = a->in[11]; const float* w_d = a->in[12];
    const float* x0 = a->in[0]; const float* x1 = a->in[1];
    constexpr int I_GU = (DM / 64) * (NGU / 32), I_D = (DFF / 64) * (DM / 32), I_QKV = (DM / 64) * (NQKV / 32), I_O = (DM / 64) * (DM / 32), I_P = (256 / 64) * (256 / 32);
    constexpr int NITEMS = 4 * I_GU + 4 * I_D + 2 * I_QKV + 2 * I_O + 8 * I_P;
    for (int it = gw; it < NITEMS; it += NGW) {
        int r = it;
        if (r < 4 * I_GU) { const int l = r / I_GU; r -= l * I_GU; transpose_item(w_gu + (size_t)l * DM * NGU, DM, NGU, (bf16*)(ws + WS_WGU) + (size_t)l * NGU * DM, norm_ffn + l * DM, 1, scr, r, lane); continue; } r -= 4 * I_GU;
        if (r < 4 * I_D) { const int l = r / I_D; r -= l * I_D; transpose_item(w_d + (size_t)l * DFF * DM, DFF, DM, (bf16*)(ws + WS_WD) + (size_t)l * DM * DFF, nullptr, 0, scr, r, lane); continue; } r -= 4 * I_D;
        if (r < 2 * I_QKV) { const int l = r / I_QKV; r -= l * I_QKV; transpose_item(w_qkv + (size_t)l * DM * NQKV, DM, NQKV, (bf16*)(ws + WS_WQKV) + (size_t)l * NQKV * DM, norm_mix + (2 * l + 1) * DM, 2, scr, r, lane); continue; } r -= 2 * I_QKV;
        if (r < 2 * I_O) { const int l = r / I_O; r -= l * I_O; transpose_item(w_o + (size_t)l * DM * DM, DM, DM, (bf16*)(ws + WS_WO) + (size_t)l * DM * DM, nullptr, 0, scr, r, lane); continue; } r -= 2 * I_O;
        { const int l = r / I_P; r -= l * I_P; transpose_item(pool_w + (size_t)l * 256 * 256, 256, 256, (bf16*)(ws + WS_WP) + (size_t)l * 256 * 256, nullptr, 0, scr, r, lane); }
    }
    for (int e = gw * 64 + lane; e < 64 * 32; e += NGW * 64) { const int pos = e >> 5, i = e & 31;
        const float inv = exp2f(-(float)(2 * i) * (1.0f / 64.0f) * 13.287712379549449f);
        const float ang = (float)pos * inv; float rev = ang * 0.15915494309189535f; rev -= floorf(rev);
        float2 cs; cs.x = __builtin_amdgcn_cosf(rev); cs.y = __builtin_amdgcn_sinf(rev);
        ((float2*)(ws + WS_ROPE))[e] = cs; }
    if (gw < 2) { const float* qg = a->in[8] + gw * HD; const float* kg = a->in[9] + gw * HD;
        float mq = fmaxf(fabsf(qg[lane]), fabsf(qg[lane + 64])), mk = fmaxf(fabsf(kg[lane]), fabsf(kg[lane + 64]));
#pragma unroll
        for (int o = 1; o < 64; o <<= 1) { mq = fmaxf(mq, __shfl_xor(mq, o)); mk = fmaxf(mk, __shfl_xor(mk, o)); }
        if (lane == 0) ((float*)(ws + WS_BOUND))[gw] = 11.313708498984761f * mq * mk * 1.02f; }
    { pg8::ss_t* ss = (pg8::ss_t*)(ws + WS_SS); for (size_t e = (size_t)gw * 64 + lane + M_TOT; e < (size_t)8 * M_TOT; e += (size_t)NGW * 64) ss[e] = 0ull; }
    { pg8::ss_t* ss = (pg8::ss_t*)(ws + WS_SS);
      for (int m = gw; m < M_TOT; m += 2 * NGW) { const int m2 = m + NGW;
          const bool has2 = m2 < M_TOT; const int mb = has2 ? m2 : m;
          const float* xa = (m < 4 * SEQ) ? x0 + (size_t)m * DM : x1 + (size_t)(m - 4 * SEQ) * DM; const float* xb_ = (mb < 4 * SEQ) ? x0 + (size_t)mb * DM : x1 + (size_t)(mb - 4 * SEQ) * DM;
          const f32x4* a4 = (const f32x4*)xa + lane; const f32x4* b4 = (const f32x4*)xb_ + lane; f32x4 va[4], vb[4];
#pragma unroll
          for (int j = 0; j < 4; ++j) { va[j] = a4[64 * j]; vb[j] = b4[64 * j]; }
          float sa = 0.f, sb = 0.f;
#pragma unroll
          for (int j = 0; j < 4; ++j) { sa += (va[j].x * va[j].x + va[j].y * va[j].y) + (va[j].z * va[j].z + va[j].w * va[j].w); sb += (vb[j].x * vb[j].x + vb[j].y * vb[j].y) + (vb[j].z * vb[j].z + vb[j].w * vb[j].w); }
          { bf16* xo = (bf16*)(ws + WS_XB);
#pragma unroll
            for (int j = 0; j < 4; ++j) { v2u wa; wa.x = pk2(va[j].x, va[j].y); wa.y = pk2(va[j].z, va[j].w); *(v2u*)(xo + (size_t)m * DM + (64 * j + lane) * 4) = wa;
                                          v2u wb; wb.x = pk2(vb[j].x, vb[j].y); wb.y = pk2(vb[j].z, vb[j].w); if (has2) *(v2u*)(xo + (size_t)m2 * DM + (64 * j + lane) * 4) = wb; } }
          sa = wave_sum(sa); sb = wave_sum(sb); if (lane == 0) { ss[m] = pg8::ss_fix(sa); if (has2) ss[m2] = pg8::ss_fix(sb); } } }
}

template <bool F32IN, int GI>
__device__ __forceinline__ void pool_item(const float* xf, const bf16* xb, const pg8::ss_t* ss, const float* g, bf16* P, int t0, int lane) {
    constexpr int HW = 1 << GI, W = 2 * HW, NR = 15 + W, ELT = F32IN ? 4 : 2;
    const int bstart = t0 & ~(SEQ - 1), c = GI * 256 + lane * 4;
    float myrs; { const int myrow = t0 - HW + lane, myrc = min(max(myrow, bstart), bstart + SEQ - 1);
        myrs = (myrow == myrc) ? pg8::ss_rsqrt(ss, myrc) : 0.f; }
    f32x4 r[NR];
    int rc = max(t0 - HW, bstart);
    const char* p = (const char*)(F32IN ? (const void*)xf : (const void*)xb) + ((size_t)rc * DM + c) * ELT;
#pragma unroll
    for (int k = 0; k < NR; ++k) {
        if (F32IN) r[k] = *(const f32x4*)p;
        else { const v2u w = *(const v2u*)p; r[k] = (f32x4){bf_lo(w.x), bf_hi(w.x), bf_lo(w.y), bf_hi(w.y)}; }
        const int rcn = min(max(t0 - HW + k + 1, bstart), bstart + SEQ - 1);
        p += (size_t)(rcn - rc) * (DM * ELT); rc = rcn; asm volatile("" : "+v"(p)); }
    const f32x4 g4 = *(const f32x4*)(g + c);
#pragma unroll
    for (int k = 0; k < NR; ++k) r[k] = r[k] * __builtin_bit_cast(float, __builtin_amdgcn_readlane(__builtin_bit_cast(int, myrs), k));
    f32x4 S = r[0];
#pragma unroll
    for (int k = 1; k < W; ++k) S += r[k];
    bf16* q = P + (size_t)t0 * DM + c;
#pragma unroll
    for (int tt = 0; tt < 16; ++tt) { const int tl = t0 + tt - bstart; const int cnt = min(tl + HW, SEQ) - max(tl - HW, 0);
        const f32x4 p4 = (S * (1.0f / (float)cnt) - r[tt + HW]) * g4;
        v2u w; w.x = pk2(p4.x, p4.y); w.y = pk2(p4.z, p4.w);
        *(v2u*)q = w; q += DM; asm volatile("" : "+v"(q));
        if (tt < 15) S += r[tt + W] - r[tt]; }
}
template <bool F32IN, int GI>
__device__ __forceinline__ void pool_loop(const float* x0, const float* x1, const bf16* xb, const pg8::ss_t* ss, const float* g, bf16* P, int gw, int NGW, int lane) {
    const int nitems = (M_TOT / 16) * 4;
    for (int it = gw; it < nitems; it += NGW) { const int t0 = (it >> 2) * 16;
        const float* xf = F32IN ? ((t0 < 4 * SEQ) ? x0 : x1 - (size_t)4 * SEQ * DM) : nullptr;
        pool_item<F32IN, GI>(xf, xb, ss, g, P, t0, lane); }
}
template <bool F32IN>
__device__ __forceinline__ void pool_prep(const float* x0, const float* x1, const bf16* xb, const pg8::ss_t* ss, const float* g, bf16* P, int gw, int NGW, int lane) {
    const int gi = gw & 3;
    if (gi == 0) pool_loop<F32IN, 0>(x0, x1, xb, ss, g, P, gw, NGW, lane);
    else if (gi == 1) pool_loop<F32IN, 1>(x0, x1, xb, ss, g, P, gw, NGW, lane);
    else if (gi == 2) pool_loop<F32IN, 2>(x0, x1, xb, ss, g, P, gw, NGW, lane);
    else pool_loop<F32IN, 3>(x0, x1, xb, ss, g, P, gw, NGW, lane);
}

#define XB_TMO      128
#define XB_XCNT(j)  (256  + 64 * (j))
#define XB_XSUB(j)  (1280 + 64 * (j))
#define XB_XGEN(j)  (2304 + 64 * (j))
#define XB_TOP      3328
#define XB_TOPGEN   3392
#define XCD_BAR_WORDS 3456
#define XB_SPIN_CAP (1u << 18)
__device__ __forceinline__ unsigned xb_ld(unsigned* p)              { return __hip_atomic_load(p, __ATOMIC_RELAXED, __HIP_MEMORY_SCOPE_AGENT); }
__device__ __forceinline__ unsigned xb_add(unsigned* p, unsigned v) { return __hip_atomic_fetch_add(p, v, __ATOMIC_RELAXED, __HIP_MEMORY_SCOPE_AGENT); }
__device__ __forceinline__ unsigned xb_xcc_id() { return (unsigned)__builtin_amdgcn_s_getreg((3 << 11) | 20) & 0xFu; }
#define XB_SPIN(cond, bar) do { unsigned _sp = 0; while (cond) { __builtin_amdgcn_s_sleep(1); \
    if ((++_sp & 255u) == 0u) { if (xb_ld(&(bar)[XB_TMO])) break; if (_sp > XB_SPIN_CAP) { atomicAdd(&(bar)[XB_TMO], 1u); break; } } } } while (0)
__device__ __forceinline__ void xcd_barrier_complete(unsigned* bar, unsigned x, unsigned& nloc, unsigned& nx) {
    const unsigned G = gridDim.x * gridDim.y * gridDim.z;
    unsigned sum, cnt, mine, sp = 0u;
    for (;;) {
        sum = 0u; cnt = 0u; mine = 0u;
#pragma unroll
        for (unsigned j = 0; j < 16; ++j) { const unsigned c = xb_ld(&bar[XB_XCNT(j)]); sum += c; cnt += (c > 0u) ? 1u : 0u; mine = (j == x) ? c : mine; }
        if (sum == G) break;
        __builtin_amdgcn_s_sleep(1);
        if ((++sp & 255u) == 0u) { if (xb_ld(&bar[XB_TMO])) break; if (sp > XB_SPIN_CAP) { atomicAdd(&bar[XB_TMO], 1u); break; } }
    }
    nloc = mine > 0u ? mine : 1u; nx = cnt > 0u ? cnt : 1u;
}
__device__ __forceinline__ void xcd_barrier(unsigned* bar, volatile LAS unsigned* st) {
    asm volatile("s_waitcnt vmcnt(0)" ::: "memory");
    __syncthreads();
    if (threadIdx.x == 0) {
        const unsigned x = xb_xcc_id();
        __builtin_amdgcn_s_waitcnt(0);
        unsigned nloc = st[0], nx = st[1];
        if (nloc == 0u) { xcd_barrier_complete(bar, x, nloc, nx); st[0] = nloc; st[1] = nx; }
        const unsigned old = xb_add(&bar[XB_XSUB(x)], 1u);
        const unsigned gen = old / nloc;
        if (old + 1u == (gen + 1u) * nloc) {
            __builtin_amdgcn_fence(__ATOMIC_RELEASE, "agent");
            asm volatile("s_waitcnt vmcnt(0)" ::: "memory");
            const unsigned og = xb_add(&bar[XB_TOP], 1u);
            const unsigned tg = og / nx;
            if (og + 1u == (tg + 1u) * nx) xb_add(&bar[XB_TOPGEN], 1u);
            else XB_SPIN(xb_ld(&bar[XB_TOPGEN]) == tg, bar);
            __builtin_amdgcn_fence(__ATOMIC_ACQUIRE, "agent");
            xb_add(&bar[XB_XGEN(x)], 1u);
            asm volatile("s_waitcnt vmcnt(0)" ::: "memory");
        } else {
            XB_SPIN(xb_ld(&bar[XB_XGEN(x)]) == gen, bar);
            __builtin_amdgcn_fence(__ATOMIC_ACQUIRE, "agent");
            asm volatile("s_waitcnt vmcnt(0)" ::: "memory");
        }
    }
    __syncthreads();
}

__device__ __forceinline__ KArgs kargs() { KArgs p = (KArgs)__builtin_amdgcn_kernarg_segment_ptr(); asm volatile("" : "+s"(p)); return p; }
struct Ctx { int G, bx, vcu, gw, NGW, wave, lane; };
__device__ __forceinline__ Ctx ctx() { Ctx c; const int tid = tid_l(); c.lane = tid & 63; c.wave = __builtin_amdgcn_readfirstlane(tid >> 6); c.G = gridDim.x; c.bx = blockIdx.x;
    c.vcu = (c.G % 8 == 0) ? (c.bx % 8) * (c.G / 8) + c.bx / 8 : c.bx;
    c.gw = c.vcu * NWAVES + c.wave; c.NGW = c.G * NWAVES; return c; }

__device__ __forceinline__ void ph_prologue(LAS unsigned char* L) { KArgs ka = kargs(); const Ctx c = ctx(); p0_prologue(ka, L, c.gw, c.NGW, c.wave, c.lane); }
__device__ __forceinline__ void ph_pool_prep(int layer) { KArgs ka = kargs(); const Ctx c = ctx(); unsigned char* ws = ka->ws;
    const pg8::ss_t* ss_mix = (const pg8::ss_t*)(ws + WS_SS) + (size_t)(2 * layer) * M_TOT;
    pool_prep<false>(nullptr, nullptr, (const bf16*)(ws + WS_XB), ss_mix, ka->in[2] + layer * DM, (bf16*)(ws + WS_P), c.gw, c.NGW, c.lane); }
__device__ __forceinline__ void ph_qkv(LAS unsigned char* L, int layer) { KArgs ka = kargs(); const Ctx c = ctx(); unsigned char* ws = ka->ws; const int j = layer >> 1;
    pg8::Gemm g{(const bf16*)(ws + WS_XB), (const bf16*)(ws + WS_WQKV) + (size_t)j * NQKV * DM, M_TOT, NQKV, DM, DM, DM, 0}; pg8::StaticOrder S; S.init(M_TOT, NQKV, c.G, c.bx);
    pg8::EpiQKV E{(bf16*)(ws + WS_QKV), (bf16*)(ws + WS_KC), (bf16*)(ws + WS_VC), (const pg8::ss_t*)(ws + WS_SS) + (size_t)(2 * layer) * M_TOT, ka->in[8] + j * HD, ka->in[9] + j * HD, (const LAS float*)(L + 131072 + 10240), (LAS float*)(L + 131072 + 1024)};
    { const int tid = tid_l(); const v4u* src = (const v4u*)(ws + WS_ROPE); LAS v4u* dst = (LAS v4u*)(L + 131072 + 10240);
      dst[tid] = src[tid]; dst[tid + 512] = src[tid + 512]; LDS_WAIT(); }
    pg8::gemm_phase<pg8::EpiQKV, pg8::StaticOrder>(L, g, S, E);
}
__device__ __forceinline__ void ph_attn(unsigned char* lds, int layer) { KArgs ka = kargs(); const Ctx c = ctx(); unsigned char* ws = ka->ws;
    const float bound = ((const float*)(ws + WS_BOUND))[layer >> 1]; const bool bounded = bound < 40.f;
    bf16* QB = (bf16*)(ws + WS_QKV); bf16* KC = (bf16*)(ws + WS_KC); bf16* VC = (bf16*)(ws + WS_VC); bf16* OB = (bf16*)(ws + WS_O);
    for (int U = c.vcu; U < NB_TOT * 2 * 64; U += c.G) {
        int grp, uu;
        if (c.G == 256) { const int i = U >> 8, xcd = c.vcu >> 5, loc = c.vcu & 31; grp = xcd + 8 * (i >> 1); uu = (i & 1) * 32 + loc; }
        else { grp = U >> 6; uu = U & 63; }
        const int b = grp >> 1, kvh = grp & 1, head = kvh * 4 + (uu >> 4), qb = uu & 15;
        const size_t rowb = (size_t)b * SEQ, row0 = rowb + (size_t)qb * 256;
        if (bounded) attn::attn_dense_body<true>((const attn::bf16*)(QB + row0 * DM + head * HD), (const attn::bf16*)(KC + (size_t)grp * SEQ * HD),
                              (const attn::bf16*)(VC + (size_t)grp * SEQ * HD), OB + row0 * DM + head * HD, SEQ, (char*)lds);
        else attn::attn_dense_body<false>((const attn::bf16*)(QB + row0 * DM + head * HD), (const attn::bf16*)(KC + (size_t)grp * SEQ * HD),
                              (const attn::bf16*)(VC + (size_t)grp * SEQ * HD), OB + row0 * DM + head * HD, SEQ, (char*)lds);
    } }
__device__ __forceinline__ void ph_mix(LAS unsigned char* L, int layer) { KArgs ka = kargs(); const Ctx c = ctx(); unsigned char* ws = ka->ws; const int j = layer >> 1;
    pg8::Gemm g; const float* mbias = nullptr; const float* mscale = nullptr;
    if ((layer & 1) == 0) { g = pg8::Gemm{(const bf16*)(ws + WS_P), (const bf16*)(ws + WS_WP) + (size_t)j * DM * 256, M_TOT, DM, 256, DM, 256, 256}; mbias = ka->in[5] + j * DM; mscale = ka->in[6] + j * DM; }
    else g = pg8::Gemm{(const bf16*)(ws + WS_O), (const bf16*)(ws + WS_WO) + (size_t)j * DM * DM, M_TOT, DM, DM, DM, DM, 0};
    pg8::StaticOrder S; S.init(M_TOT, DM, c.G, c.bx);
    const float* b_lo = nullptr; const float* b_hi = nullptr;
    pg8::EpiRes E{b_lo, b_hi, 4 * SEQ / 256, nullptr, (bf16*)(ws + WS_XB), (pg8::ss_t*)(ws + WS_SS) + (size_t)(2 * layer + 1) * M_TOT, mbias, mscale};
    pg8::gemm_phase<pg8::EpiRes, pg8::StaticOrder>(L, g, S, E);
}
__device__ __forceinline__ void ph_gateup(LAS unsigned char* L, int layer) { KArgs ka = kargs(); const Ctx c = ctx(); unsigned char* ws = ka->ws;
    pg8::Gemm g{(const bf16*)(ws + WS_XB), (const bf16*)(ws + WS_WGU) + (size_t)layer * NGU * DM, M_TOT, NGU, DM, DM, DM, 0}; pg8::StaticOrder S; S.init(M_TOT, NGU, c.G, c.bx);
    pg8::EpiSwiGLU E{(bf16*)(ws + WS_H), (const pg8::ss_t*)(ws + WS_SS) + (size_t)(2 * layer + 1) * M_TOT};
    pg8::gemm_phase<pg8::EpiSwiGLU, pg8::StaticOrder>(L, g, S, E);
}
__device__ __forceinline__ void ph_down(LAS unsigned char* L, int layer) { KArgs ka = kargs(); const Ctx c = ctx(); unsigned char* ws = ka->ws;
    pg8::Gemm g{(const bf16*)(ws + WS_H), (const bf16*)(ws + WS_WD) + (size_t)layer * DM * DFF, M_TOT, DM, DFF, DFF, DFF, 0}; pg8::StaticOrder S; S.init(M_TOT, DM, c.G, c.bx);
    pg8::EpiRes E{nullptr, nullptr, 0, (layer < 3) ? nullptr : ka->out, (bf16*)(ws + WS_XB), (layer < 3) ? (pg8::ss_t*)(ws + WS_SS) + (size_t)(2 * layer + 2) * M_TOT : nullptr, nullptr, nullptr};
    pg8::gemm_phase<pg8::EpiRes, pg8::StaticOrder>(L, g, S, E);
}

__global__ void __launch_bounds__(NWAVES * 64, 2) mk_fwd(Args args) {
    extern __shared__ __attribute__((aligned(16))) unsigned char lds[];
    cg::grid_group grid = cg::this_grid();
    LAS unsigned char* L = (LAS unsigned char*)lds;
    const int lo = args.ph_lo, hi = args.ph_hi;
    if (threadIdx.x < 2) ((volatile LAS unsigned*)(L + 131072 + 256))[threadIdx.x] = 0u;
    __syncthreads();
    if (MK_N_LAUNCHES == 1 && threadIdx.x == 0) (void)xb_add((unsigned*)(args.ws + WS_BAR) + XB_XCNT(xb_xcc_id()), 1u);
#define RUN(k) (lo <= (k) && (k) < hi)
#define SEAM(k) do { if (RUN(k) && RUN((k) + 1)) { KArgs ka_ = kargs(); xcd_barrier((unsigned*)(ka_->ws + WS_BAR), (volatile LAS unsigned*)(L + 131072 + 256)); } } while (0)
    int ph = 0;
    if (RUN(ph)) ph_prologue(L);
    if (args.ph_lo < -1) grid.sync();
    SEAM(ph);
    ++ph;
    for (int layer = 0; layer < 4; ++layer) {
        if ((layer & 1) == 0) {
            if (RUN(ph)) ph_pool_prep(layer);
            SEAM(ph); ++ph;
        } else {
            if (RUN(ph)) ph_qkv(L, layer);
            SEAM(ph); ++ph;
            if (RUN(ph)) ph_attn(lds, layer);
            SEAM(ph); ++ph;
        }
        if (RUN(ph)) ph_mix(L, layer);
        SEAM(ph); ++ph;
        if (RUN(ph)) ph_gateup(L, layer);
        SEAM(ph); ++ph;
        if (RUN(ph)) ph_down(L, layer);
        SEAM(ph); ++ph;
    }
#undef RUN
#undef SEAM
}

extern "C" void kernel_launch(void* const* d_in, const int* in_sizes, int n_in, void* d_out, int out_size, void* d_ws, size_t ws_size, hipStream_t stream) {
    static int grid = 0;
    if (grid == 0) {
        if (n_in != 13 || in_sizes[0] != 4 * SEQ * DM || in_sizes[1] != 8 * SEQ * DM || out_size != M_TOT * DM || ws_size < WS_END) {
            fprintf(stderr, "kernel_launch: shape mismatch n_in %d in0 %d in1 %d out %d ws %zu\n", n_in, n_in > 0 ? in_sizes[0] : -1, n_in > 1 ? in_sizes[1] : -1, out_size, ws_size); grid = -1; return; }
        int dev = 0, cus = 0, per_cu = 0;
        if (hipGetDevice(&dev) != hipSuccess || hipDeviceGetAttribute(&cus, hipDeviceAttributeMultiprocessorCount, dev) != hipSuccess) { grid = -1; return; }
        if (hipFuncSetAttribute((const void*)mk_fwd, hipFuncAttributeMaxDynamicSharedMemorySize, LDS_BYTES) != hipSuccess) { fprintf(stderr, "kernel_launch: hipFuncSetAttribute failed\n"); grid = -1; return; }
        if (hipOccupancyMaxActiveBlocksPerMultiprocessor(&per_cu, (const void*)mk_fwd, NWAVES * 64, LDS_BYTES) != hipSuccess || per_cu < 1) { fprintf(stderr, "kernel_launch: occupancy query says %d\n", per_cu); per_cu = 1; }
        (void)hipGetLastError();
        grid = cus * (per_cu > 1 ? 1 : per_cu);
    }
    if (grid < 0) return;
    if (hipMemsetAsync((char*)d_ws + WS_BAR, 0, 16384, stream) != hipSuccess) { fprintf(stderr, "kernel_launch: memset of the barrier words failed\n"); return; }
    Args a{};
    for (int i = 0; i < 13; ++i) a.in[i] = (const float*)d_in[i];
    a.out = (float*)d_out; a.ws = (unsigned char*)d_ws;
#if MK_N_LAUNCHES == 1
    a.ph_lo = 0; a.ph_hi = N_PHASES;
    void* kargs[] = {&a};
    hipError_t e = hipLaunchCooperativeKernel((const void*)mk_fwd, dim3(grid), dim3(NWAVES * 64), kargs, LDS_BYTES, stream);
    if (e != hipSuccess) fprintf(stderr, "kernel_launch: cooperative launch failed: %s (grid %d)\n", hipGetErrorString(e), grid);
#else
    for (int p = 0; p < N_PHASES; ++p) { a.ph_lo = p; a.ph_hi = p + 1;
        hipLaunchKernelGGL(mk_fwd, dim3(grid), dim3(NWAVES * 64), LDS_BYTES, stream, a);
        const hipError_t le = hipPeekAtLastError();
        if (le != hipSuccess) { fprintf(stderr, "kernel_launch: launch %d failed: %s\n", p, hipGetErrorName(le)); break; } }
#endif
}
```

```cpp
#include <hip/hip_runtime.h>
#include <hip/hip_bf16.h>
#include <hip/hip_cooperative_groups.h>
#include <cstdio>
#include <cstdint>
namespace cg = cooperative_groups;

#ifndef MK_N_LAUNCHES
#define MK_N_LAUNCHES 1
#endif

constexpr int DM = 1024, SEQ = 4096, NB_TOT = 12, M_TOT = NB_TOT * SEQ;
constexpr int DFF = 2816, NGU = 2 * DFF, NQKV = 1536, HD = 128;
constexpr float EPS = 1e-6f;
constexpr int N_PHASES = 19;

constexpr size_t MiB = 1u << 20;
constexpr size_t WS_ROPE = 0;
constexpr size_t WS_BOUND = 32768;
constexpr size_t WS_BAR = 2 * MiB - 65536;
constexpr size_t WS_WGU = 2 * MiB;
constexpr size_t WS_WD = 46 * MiB;
constexpr size_t WS_WQKV = 68 * MiB;
constexpr size_t WS_WO = 74 * MiB;
constexpr size_t WS_WP = 78 * MiB;
constexpr size_t WS_XB = 80 * MiB;
constexpr size_t WS_H = 176 * MiB;
constexpr size_t WS_QKV = 176 * MiB;
constexpr size_t WS_KC = 272 * MiB;
constexpr size_t WS_VC = 296 * MiB;
constexpr size_t WS_O = 320 * MiB;
constexpr size_t WS_P = 176 * MiB;
constexpr size_t WS_SS = 440 * MiB;
constexpr size_t WS_END = 444 * MiB;
static_assert(WS_ROPE + 64 * 32 * 8 <= WS_BAR && WS_BAR + 16384 <= WS_WGU && WS_WGU + (size_t)4 * NGU * DM * 2 <= WS_WD && WS_WD + (size_t)4 * DM * DFF * 2 <= WS_WQKV, "ws map 1");
static_assert(WS_WQKV + (size_t)2 * NQKV * DM * 2 <= WS_WO && WS_WO + (size_t)2 * DM * DM * 2 <= WS_WP && WS_WP + (size_t)2 * DM * 256 * 2 <= WS_XB, "ws map 2");
static_assert(WS_XB + (size_t)M_TOT * DM * 2 <= WS_H && WS_H + (size_t)M_TOT * DFF * 2 <= WS_SS && WS_SS + (size_t)8 * M_TOT * 8 <= WS_END && WS_QKV + (size_t)M_TOT * DM * 2 <= WS_KC && WS_KC + (size_t)M_TOT * 256 * 2 <= WS_VC && WS_VC + (size_t)M_TOT * 256 * 2 <= WS_O && WS_O + (size_t)M_TOT * DM * 2 <= WS_END, "ws map 3");

__device__ __forceinline__ int tid_l() { int t = threadIdx.x; asm volatile("" : "+v"(t)); return t; }
constexpr int LDS_BYTES = 131072 + 26624;
constexpr int NWAVES = 8;

namespace pg8 {
#define PG8_LAS __attribute__((address_space(3)))
typedef unsigned short bf16_t;
typedef short bf16x8 __attribute__((ext_vector_type(8)));
typedef float f32x4 __attribute__((ext_vector_type(4)));
typedef unsigned u32x4 __attribute__((ext_vector_type(4)));
typedef unsigned u32x2 __attribute__((ext_vector_type(2)));
constexpr int BM = 256, BK = 64, HALF = 128, HTB = HALF * BK * 2, STAGE_BYTES = 8 * HTB, NXCD = 8, WGM = 8;

__host__ __device__ __forceinline__ int lds_byte(int r, int c) { const int st = (r >> 4) * 2 + (c >> 5), rr = r & 15, cc = c & 31, ob = rr * 64 + cc * 2; return st * 1024 + (ob ^ (((ob >> 9) & 1) << 5)); }
__host__ __device__ __forceinline__ void stage_rc(int b, int& R, int& C) { const int st = b / 1024, sb = b % 1024, swz = sb ^ (((sb >> 9) & 1) << 5); R = (st >> 1) * 16 + swz / 64; C = (st & 1) * 32 + (swz % 64) / 2; }
__host__ __device__ __forceinline__ int perm32(int rho) { const int n = rho >> 4, i = rho & 15; return 8 * (i >> 2) + 4 * n + (i & 3); }

struct Unit { int pm, pn; };
struct Gemm { const bf16_t* A; const bf16_t* Bt; int M, N, K, lda, ldb, a_pn_cols; };

struct StaticOrder {
    int nM, nN, nwg, G, c;
    __host__ __device__ void init(int M, int N, int G_, int c_) { nM = M / BM; nN = N / BM; nwg = nM * nN; G = G_; c = c_; }
    __host__ __device__ bool next(int i, Unit& u) const {
        const long L = (long)i * G + c; if (L >= nwg) return false;
        int wgid = (int)L; { const int q = nwg / NXCD, r = nwg % NXCD, xcd = wgid % NXCD, off = wgid / NXCD; wgid = (xcd < r ? xcd * (q + 1) : r * (q + 1) + (xcd - r) * q) + off; }
        const int nig = WGM * nN, gid = wgid / nig, fm = gid * WGM, gsz = (nM - fm) < WGM ? (nM - fm) : WGM;
        u.pm = fm + ((wgid % nig) % gsz); u.pn = (wgid % nig) / gsz; return true;
    }
};

__device__ __forceinline__ unsigned cvt_pk_bf16(float lo, float hi) { unsigned r; asm("v_cvt_pk_bf16_f32 %0, %1, %2" : "=v"(r) : "v"(lo), "v"(hi)); return r; }
typedef unsigned long long ss_t;
__device__ __forceinline__ float ss_rsqrt(const ss_t* ss, int row) { return __builtin_amdgcn_rsqf((float)ss[row] * (1.0f / 16777216.0f / DM) + EPS); }
__device__ __forceinline__ ss_t ss_fix(float sq) { return (ss_t)(sq * 16777216.0f + 0.5f); }
__device__ __forceinline__ void ss_rsqrt8(const ss_t* ss, int row0, float (&r)[2][4]) {
    ss_t v[2][4];
#pragma unroll
    for (int ai = 0; ai < 2; ++ai)
#pragma unroll
        for (int m = 0; m < 4; ++m) v[ai][m] = ss[row0 + ai * HALF + m * 16];
#pragma unroll
    for (int ai = 0; ai < 2; ++ai)
#pragma unroll
        for (int m = 0; m < 4; ++m) r[ai][m] = __builtin_amdgcn_rsqf((float)v[ai][m] * (1.0f / 16777216.0f / DM) + EPS);
}


struct EpiQKV {
    static constexpr bool PERM = true;
    bf16_t* Q; bf16_t* Kc; bf16_t* Vc; const ss_t* ss; const float* q_gain; const float* k_gain; const PG8_LAS float* rope; PG8_LAS float* part;
    __device__ __forceinline__ static size_t kv_off(int row, int bj) { return ((size_t)((row >> 12) * 2 + bj) * SEQ + (row & (SEQ - 1))) * HD; }
    __device__ __forceinline__ void operator()(const f32x4 (&acc)[2][2][4][2], const Unit& u, int wr, int wc, int fr, int fq) const {
        const int row0 = u.pm * BM + wr * 64 + fr, col0 = u.pn * BM + wc * 32 + 8 * fq;
        if (u.pn >= 5) {
#pragma unroll
            for (int ai = 0; ai < 2; ++ai)
#pragma unroll
                for (int m = 0; m < 4; ++m) { const int row = row0 + ai * HALF + m * 16; const float r = ss_rsqrt(ss, row);
#pragma unroll
                    for (int bj = 0; bj < 2; ++bj) { const f32x4 v0 = acc[ai][bj][m][0] * r, v1 = acc[ai][bj][m][1] * r;
                        u32x4 w; w.x = cvt_pk_bf16(v0[0], v0[1]); w.y = cvt_pk_bf16(v0[2], v0[3]); w.z = cvt_pk_bf16(v1[0], v1[1]); w.w = cvt_pk_bf16(v1[2], v1[3]);
                        *(u32x4*)(Vc + kv_off(row, bj) + wc * 32 + 8 * fq) = w; } }
            return;
        }
        float rr[2][4];
#pragma unroll
        for (int ai = 0; ai < 2; ++ai)
#pragma unroll
            for (int m = 0; m < 4; ++m) { const int rl = ai * HALF + wr * 64 + m * 16 + fr; const float r = ss_rsqrt(ss, u.pm * BM + rl); rr[ai][m] = r;
#pragma unroll
                for (int bj = 0; bj < 2; ++bj) { const f32x4 a = acc[ai][bj][m][0], b = acc[ai][bj][m][1];
                    float sq = ((a[0] * a[0] + a[1] * a[1]) + (a[2] * a[2] + a[3] * a[3])) + ((b[0] * b[0] + b[1] * b[1]) + (b[2] * b[2] + b[3] * b[3]));
                    sq += __shfl_xor(sq, 16); sq += __shfl_xor(sq, 32);
                    if (fq == 0) part[(rl * 2 + bj) * 4 + wc] = sq * r * r; } }
        asm volatile("s_waitcnt lgkmcnt(0)" ::: "memory"); __builtin_amdgcn_s_barrier(); asm volatile("" ::: "memory");
        const int half = wc >> 1, ib = (wc & 1) * 16 + 4 * fq; const float qsc = (u.pn == 4) ? 1.0f : 0.12752041570284543f;
        const float* gn = (u.pn == 4 ? k_gain : q_gain) + half * 64 + ib;
        const f32x4 g1 = *(const f32x4*)gn, g2 = *(const f32x4*)(gn + 32);
#pragma unroll
        for (int ai = 0; ai < 2; ++ai)
#pragma unroll
            for (int m = 0; m < 4; ++m) { const int rl = ai * HALF + wr * 64 + m * 16 + fr, row = u.pm * BM + rl, t = row & (SEQ - 1), pos = half ? (t & 63) : (t >> 6);
                const f32x4 cs01 = *(const PG8_LAS f32x4*)(rope + (pos * 32 + ib) * 2), cs23 = *(const PG8_LAS f32x4*)(rope + (pos * 32 + ib) * 2 + 4);
#pragma unroll
                for (int bj = 0; bj < 2; ++bj) { const f32x4 p4 = *(const PG8_LAS f32x4*)(part + (rl * 2 + bj) * 4);
                    bf16_t* dst = (u.pn == 4) ? Kc + kv_off(row, bj) + wc * 32 + 8 * fq : Q + (size_t)row * DM + col0 + bj * HALF;
                    const float rn = __builtin_amdgcn_rsqf(((p4[0] + p4[1]) + (p4[2] + p4[3])) * (1.0f / HD) + EPS) * rr[ai][m] * qsc;
                    const f32x4 a = acc[ai][bj][m][0] * rn, b = acc[ai][bj][m][1] * rn;
                    const float x10 = a[0] * g1[0], x20 = a[1] * g2[0], x11 = a[2] * g1[1], x21 = a[3] * g2[1], x12 = b[0] * g1[2], x22 = b[1] * g2[2], x13 = b[2] * g1[3], x23 = b[3] * g2[3];
                    u32x4 w;
                    w.x = cvt_pk_bf16(x10 * cs01[0] - x20 * cs01[1], x20 * cs01[0] + x10 * cs01[1]);
                    w.y = cvt_pk_bf16(x11 * cs01[2] - x21 * cs01[3], x21 * cs01[2] + x11 * cs01[3]);
                    w.z = cvt_pk_bf16(x12 * cs23[0] - x22 * cs23[1], x22 * cs23[0] + x12 * cs23[1]);
                    w.w = cvt_pk_bf16(x13 * cs23[2] - x23 * cs23[3], x23 * cs23[2] + x13 * cs23[3]);
                    *(u32x4*)dst = w; } }
    }
};
struct EpiSwiGLU {
    static constexpr bool PERM = true;
    bf16_t* H; const ss_t* ss;
    __device__ __forceinline__ void operator()(const f32x4 (&acc)[2][2][4][2], const Unit& u, int wr, int wc, int fr, int fq) const {
        const int row0 = u.pm * BM + wr * 64 + fr, col0 = u.pn * HALF + wc * 32 + 8 * fq;
        float rr[2][4]; ss_rsqrt8(ss, row0, rr);
#pragma unroll
        for (int ai = 0; ai < 2; ++ai)
#pragma unroll
            for (int m = 0; m < 4; ++m) { const int row = row0 + ai * HALF + m * 16; const float r = rr[ai][m];
                typedef float f32x2 __attribute__((ext_vector_type(2)));
                const float rn = r * -1.4426950408889634f, r2 = r * r;
                unsigned hw[4];
#pragma unroll
                for (int n = 0; n < 2; ++n)
#pragma unroll
                    for (int jp = 0; jp < 2; ++jp) { const f32x2 g = {acc[ai][0][m][n][2 * jp], acc[ai][0][m][n][2 * jp + 1]}, uu = {acc[ai][1][m][n][2 * jp], acc[ai][1][m][n][2 * jp + 1]};
                        const f32x2 t = g * rn; f32x2 e; e.x = __builtin_amdgcn_exp2f(t.x); e.y = __builtin_amdgcn_exp2f(t.y);
                        const f32x2 d = e + 1.0f; f32x2 rc; rc.x = __builtin_amdgcn_rcpf(d.x); rc.y = __builtin_amdgcn_rcpf(d.y);
                        const f32x2 h = (g * uu) * (rc * r2);
                        hw[n * 2 + jp] = cvt_pk_bf16(h.x, h.y); }
                u32x4 w; w.x = hw[0]; w.y = hw[1]; w.z = hw[2]; w.w = hw[3];
                *(u32x4*)(H + (size_t)row * DFF + col0) = w; }
    }
};
struct EpiRes {
    static constexpr bool PERM = true;
    const float* xin_lo; const float* xin_hi; int split_pm; float* out; bf16_t* xb; ss_t* ss; const float* bias; const float* scale;
    template <bool F32, int NM>
    __device__ __forceinline__ void rows(const f32x4 (&acc)[2][2][4][2], const float* xin, int ai, int m0, int row0, int col0, int fq, const f32x4 (&bv)[2][2], const f32x4 (&sv)[2][2]) const {
        const size_t off0 = (size_t)(row0 + ai * HALF + m0 * 16) * DM + col0;
        f32x4 b[NM][2][2];
        if (F32) {
#pragma unroll
            for (int m = 0; m < NM; ++m)
#pragma unroll
                for (int bj = 0; bj < 2; ++bj)
#pragma unroll
                    for (int n = 0; n < 2; ++n) b[m][bj][n] = *(const f32x4*)(xin + off0 + (size_t)m * 16 * DM + bj * HALF + 4 * n);
        } else {
            u32x4 w[NM][2];
#pragma unroll
            for (int m = 0; m < NM; ++m)
#pragma unroll
                for (int bj = 0; bj < 2; ++bj) w[m][bj] = *(const u32x4*)(xb + off0 + (size_t)m * 16 * DM + bj * HALF);
#pragma unroll
            for (int m = 0; m < NM; ++m)
#pragma unroll
                for (int bj = 0; bj < 2; ++bj) {
                    b[m][bj][0] = (f32x4){__builtin_bit_cast(float, w[m][bj].x << 16), __builtin_bit_cast(float, w[m][bj].x & 0xffff0000u), __builtin_bit_cast(float, w[m][bj].y << 16), __builtin_bit_cast(float, w[m][bj].y & 0xffff0000u)};
                    b[m][bj][1] = (f32x4){__builtin_bit_cast(float, w[m][bj].z << 16), __builtin_bit_cast(float, w[m][bj].z & 0xffff0000u), __builtin_bit_cast(float, w[m][bj].w << 16), __builtin_bit_cast(float, w[m][bj].w & 0xffff0000u)}; }
        }
#pragma unroll
        for (int m = 0; m < NM; ++m) { const int row = row0 + ai * HALF + (m0 + m) * 16; const size_t off = off0 + (size_t)m * 16 * DM; float sq = 0.f;
#pragma unroll
            for (int bj = 0; bj < 2; ++bj) { f32x4 o[2];
#pragma unroll
                for (int n = 0; n < 2; ++n) { f32x4 v = acc[ai][bj][m0 + m][n];
                    if (bias) v = (v + bv[bj][n]) * sv[bj][n];
                    o[n] = b[m][bj][n] + v;
                    sq += (o[n][0] * o[n][0] + o[n][1] * o[n][1]) + (o[n][2] * o[n][2] + o[n][3] * o[n][3]); }
                if (out) { *(f32x4*)(out + off + bj * HALF) = o[0]; *(f32x4*)(out + off + bj * HALF + 4) = o[1]; }
                else { u32x4 w; w.x = cvt_pk_bf16(o[0][0], o[0][1]); w.y = cvt_pk_bf16(o[0][2], o[0][3]); w.z = cvt_pk_bf16(o[1][0], o[1][1]); w.w = cvt_pk_bf16(o[1][2], o[1][3]); *(u32x4*)(xb + off + bj * HALF) = w; } }
            if (ss) { sq += __shfl_xor(sq, 16); sq += __shfl_xor(sq, 32); if (fq == 0) atomicAdd(ss + row, ss_fix(sq)); } }
        asm volatile("" ::: "memory");
    }
    __device__ __forceinline__ void operator()(const f32x4 (&acc)[2][2][4][2], const Unit& u, int wr, int wc, int fr, int fq) const {
        const int col0 = u.pn * BM + wc * 32 + 8 * fq, row0 = u.pm * BM + wr * 64 + fr;
        const float* xin = (u.pm < split_pm) ? xin_lo : xin_hi;
        f32x4 bv[2][2], sv[2][2];
#pragma unroll
        for (int bj = 0; bj < 2; ++bj)
#pragma unroll
            for (int n = 0; n < 2; ++n) { bv[bj][n] = bias ? *(const f32x4*)(bias + col0 + bj * HALF + 4 * n) : (f32x4){0.f, 0.f, 0.f, 0.f}; sv[bj][n] = bias ? *(const f32x4*)(scale + col0 + bj * HALF + 4 * n) : (f32x4){1.f, 1.f, 1.f, 1.f}; }
        if (xin) {
#pragma unroll
            for (int ai = 0; ai < 2; ++ai) { rows<true, 2>(acc, xin, ai, 0, row0, col0, fq, bv, sv); rows<true, 2>(acc, xin, ai, 2, row0, col0, fq, bv, sv); }
        } else if (bias) {
#pragma unroll
            for (int ai = 0; ai < 2; ++ai) rows<false, 4>(acc, xin, ai, 0, row0, col0, fq, bv, sv);
        } else {
            u32x4 w[2][4][2];
#pragma unroll
            for (int ai = 0; ai < 2; ++ai)
#pragma unroll
                for (int m = 0; m < 4; ++m)
#pragma unroll
                    for (int bj = 0; bj < 2; ++bj) w[ai][m][bj] = *(const u32x4*)(xb + (size_t)(row0 + ai * HALF + m * 16) * DM + col0 + bj * HALF);
#pragma unroll
            for (int ai = 0; ai < 2; ++ai)
#pragma unroll
                for (int m = 0; m < 4; ++m) { const int row = row0 + ai * HALF + m * 16; const size_t off = (size_t)row * DM + col0; float sq = 0.f;
#pragma unroll
                    for (int bj = 0; bj < 2; ++bj) { const u32x4 ww = w[ai][m][bj]; f32x4 o[2];
                        const f32x4 b0 = (f32x4){__builtin_bit_cast(float, ww.x << 16), __builtin_bit_cast(float, ww.x & 0xffff0000u), __builtin_bit_cast(float, ww.y << 16), __builtin_bit_cast(float, ww.y & 0xffff0000u)};
                        const f32x4 b1 = (f32x4){__builtin_bit_cast(float, ww.z << 16), __builtin_bit_cast(float, ww.z & 0xffff0000u), __builtin_bit_cast(float, ww.w << 16), __builtin_bit_cast(float, ww.w & 0xffff0000u)};
#pragma unroll
                        for (int n = 0; n < 2; ++n) { o[n] = (n ? b1 : b0) + acc[ai][bj][m][n];
                            sq += (o[n][0] * o[n][0] + o[n][1] * o[n][1]) + (o[n][2] * o[n][2] + o[n][3] * o[n][3]); }
                        if (out) { *(f32x4*)(out + off + bj * HALF) = o[0]; *(f32x4*)(out + off + bj * HALF + 4) = o[1]; }
                        else { u32x4 r; r.x = cvt_pk_bf16(o[0][0], o[0][1]); r.y = cvt_pk_bf16(o[0][2], o[0][3]); r.z = cvt_pk_bf16(o[1][0], o[1][1]); r.w = cvt_pk_bf16(o[1][2], o[1][3]); *(u32x4*)(xb + off + bj * HALF) = r; } }
                    if (ss) { sq += __shfl_xor(sq, 16); sq += __shfl_xor(sq, 32); if (fq == 0) atomicAdd(ss + row, ss_fix(sq)); } }
        }
    }
};

template <class Epi, class Sched>
__device__ __forceinline__ void gemm_phase(PG8_LAS unsigned char* lds, const Gemm g, const Sched& S, const Epi& E) {
    const int tid = tid_l(), wid = __builtin_amdgcn_readfirstlane(tid >> 6), lane = tid & 63, wr = wid >> 2, wc = wid & 3, fr = lane & 15, fq = lane >> 4;
    const int K = g.K, nt = K / BK;
    unsigned voffA[2], voffB[2];
#pragma unroll
    for (int i = 0; i < 2; ++i) { int R, C; stage_rc(tid * 16 + i * 8192, R, C); const int Rb = Epi::PERM ? ((R & ~31) + perm32(R & 31)) : R;
        voffA[i] = (unsigned)(R * g.lda + C) * 2u; voffB[i] = (unsigned)(Rb * g.ldb + C) * 2u; }
    const size_t kstep = (size_t)(BK * 2);
    const size_t hstepA = (size_t)HALF * g.lda * 2, hstepB = (size_t)HALF * g.ldb * 2;
    const size_t tstepA = 2 * hstepA, tstepB = 2 * hstepB, pnstepA = (size_t)g.a_pn_cols * 2;
    const unsigned ldsw = (unsigned)wid * 1024u;
    const int aoff = lds_byte(wr * 64 + fr, fq * 8), boff = lds_byte(wc * 32 + fr, fq * 8);
#define PG8_SA(b, h) (((b) * 2 + (h)) * HTB)
#define PG8_SB(b, h) ((4 + (b) * 2 + (h)) * HTB)
#define PG8_STAGE(bufoff, gbase, voff) do { _Pragma("unroll") for (int _i = 0; _i < 2; ++_i) \
        __builtin_amdgcn_global_load_lds((const unsigned*)((const char*)(gbase) + (voff)[_i]), (PG8_LAS unsigned*)(lds + (bufoff) + ldsw + _i * 8192), 16, 0, 0); } while (0)
#define PG8_LDA(dst, b, h) do { _Pragma("unroll") for (int m = 0; m < 4; ++m) _Pragma("unroll") for (int k = 0; k < 2; ++k) dst[m][k] = *(const PG8_LAS bf16x8*)(lds + PG8_SA(b, h) + aoff + m * 2048 + k * 1024); } while (0)
#define PG8_LDB(dst, b, h) do { _Pragma("unroll") for (int n = 0; n < 2; ++n) _Pragma("unroll") for (int k = 0; k < 2; ++k) dst[n][k] = *(const PG8_LAS bf16x8*)(lds + PG8_SB(b, h) + boff + n * 2048 + k * 1024); } while (0)
#define PG8_MMA(ai, bj, At, Bt) do { __builtin_amdgcn_s_setprio(1); _Pragma("unroll") for (int m = 0; m < 4; ++m) _Pragma("unroll") for (int n = 0; n < 2; ++n) _Pragma("unroll") for (int k = 0; k < 2; ++k) \
        acc[ai][bj][m][n] = __builtin_amdgcn_mfma_f32_16x16x32_bf16(Bt[n][k], At[m][k], acc[ai][bj][m][n], 0, 0, 0); __builtin_amdgcn_s_setprio(0); } while (0)
#define PG8_WAIT_V(n) asm volatile("s_waitcnt vmcnt(" #n ")" ::: "memory")
#define PG8_WAIT_L(n) asm volatile("s_waitcnt lgkmcnt(" #n ")" ::: "memory")
#define PG8_BAR __builtin_amdgcn_s_barrier()
#define PG8_SCHED __builtin_amdgcn_sched_barrier(0)
    Unit cur, nxt; int ui = 0;
    if (!S.next(0, cur)) return;
    f32x4 acc[2][2][4][2];
#pragma unroll
    for (int a = 0; a < 2; ++a)
#pragma unroll
        for (int b = 0; b < 2; ++b)
#pragma unroll
            for (int m = 0; m < 4; ++m)
#pragma unroll
                for (int n = 0; n < 2; ++n) acc[a][b][m][n] = (f32x4){0.f, 0.f, 0.f, 0.f};
    bf16x8 At[4][2], B0[2][2], B1[2][2];
    const char* cA = (const char*)g.A + (size_t)cur.pm * tstepA + (size_t)cur.pn * pnstepA; const char* cB = (const char*)g.Bt + (size_t)cur.pn * tstepB;
    PG8_STAGE(PG8_SB(0, 0), cB, voffB); PG8_STAGE(PG8_SB(0, 1), cB + hstepB, voffB); PG8_STAGE(PG8_SA(0, 0), cA, voffA); PG8_STAGE(PG8_SA(0, 1), cA + hstepA, voffA);
    if (wr == 1) PG8_BAR;
    PG8_WAIT_V(2); PG8_BAR;
    PG8_STAGE(PG8_SB(1, 0), cB + kstep, voffB); PG8_STAGE(PG8_SA(1, 0), cA + kstep, voffA); PG8_STAGE(PG8_SB(1, 1), cB + hstepB + kstep, voffB);
    PG8_WAIT_V(6); PG8_BAR;
    for (;;) {
        const bool has_next = S.next(ui + 1, nxt);
        const char* nA = has_next ? (const char*)g.A + (size_t)nxt.pm * tstepA + (size_t)nxt.pn * pnstepA : cA; const char* nB = has_next ? (const char*)g.Bt + (size_t)nxt.pn * tstepB : cB;
        for (int t = 0; t < nt; t += 2) {
            const bool last = (t == nt - 2);
            const char* a1 = cA + (size_t)(t + 1) * kstep;
            const char* a2 = last ? nA : cA + (size_t)(t + 2) * kstep; const char* b2 = last ? nB : cB + (size_t)(t + 2) * kstep;
            const char* a3 = a2 + kstep; const char* b3 = b2 + kstep;
            PG8_STAGE(PG8_SA(1, 1), a1 + hstepA, voffA); PG8_SCHED; PG8_LDB(B0, 0, 0); PG8_LDB(B1, 0, 1); PG8_SCHED; PG8_LDA(At, 0, 0);
            PG8_WAIT_V(8); PG8_WAIT_L(0); PG8_BAR; PG8_MMA(0, 0, At, B0); PG8_MMA(0, 1, At, B1); PG8_BAR; PG8_SCHED;
            PG8_STAGE(PG8_SB(0, 0), b2, voffB); PG8_STAGE(PG8_SB(0, 1), b2 + hstepB, voffB); PG8_STAGE(PG8_SA(0, 0), a2, voffA); PG8_SCHED; PG8_LDA(At, 0, 1);
            PG8_WAIT_V(8); PG8_WAIT_L(0); PG8_BAR; PG8_MMA(1, 0, At, B0); PG8_MMA(1, 1, At, B1); PG8_BAR; PG8_SCHED;
            PG8_STAGE(PG8_SA(0, 1), a2 + hstepA, voffA); PG8_SCHED; PG8_LDB(B0, 1, 0); PG8_LDB(B1, 1, 1); PG8_SCHED; PG8_LDA(At, 1, 0);
            PG8_WAIT_V(8); PG8_WAIT_L(0); PG8_BAR; PG8_MMA(0, 0, At, B0); PG8_MMA(0, 1, At, B1); PG8_BAR; PG8_SCHED;
            PG8_STAGE(PG8_SB(1, 0), b3, voffB); PG8_STAGE(PG8_SB(1, 1), b3 + hstepB, voffB); PG8_STAGE(PG8_SA(1, 0), a3, voffA); PG8_SCHED; PG8_LDA(At, 1, 1);
            PG8_WAIT_V(8); PG8_WAIT_L(0); PG8_BAR; PG8_MMA(1, 0, At, B0); PG8_MMA(1, 1, At, B1); PG8_BAR; PG8_SCHED;
        }
        if (wr == 0) PG8_BAR;
        E(acc, cur, wr, wc, fr, fq);
        if (!has_next) break;
#pragma unroll
        for (int a = 0; a < 2; ++a)
#pragma unroll
            for (int b = 0; b < 2; ++b)
#pragma unroll
                for (int m = 0; m < 4; ++m)
#pragma unroll
                    for (int n = 0; n < 2; ++n) acc[a][b][m][n] = (f32x4){0.f, 0.f, 0.f, 0.f};
        cur = nxt; cA = nA; cB = nB; ++ui;
        if (wr == 1) PG8_BAR;
    }
    PG8_WAIT_V(0);
    PG8_BAR;
#undef PG8_SA
#undef PG8_SB
#undef PG8_STAGE
#undef PG8_LDA
#undef PG8_LDB
#undef PG8_MMA
#undef PG8_WAIT_V
#undef PG8_WAIT_L
#undef PG8_BAR
#undef PG8_SCHED
}
}

namespace attn {
using bf16 = __hip_bfloat16;
constexpr int D = 128, NW = 8, QBLK = 32, KVBLK = 64;
constexpr float SCALE = 0.088388347648318440f;
constexpr float QSCALE = SCALE * 1.4426950408889634f;
constexpr float THR = 8.f;
constexpr int SDEPTH = 2;
constexpr int LDQ = DM, LDK = HD, LDO = DM;
constexpr size_t SHM_V = KVBLK * D * 2, SHM_K = KVBLK * D * 2, SHM_ATTN = 2 * SHM_V + 2 * SHM_K + NW * 64 * 4;
using bf16x8 = __attribute__((ext_vector_type(8))) short;
using s16x4  = __attribute__((ext_vector_type(4))) short;
using f32x16 = __attribute__((ext_vector_type(16))) float;
using u32x4  = __attribute__((ext_vector_type(4))) unsigned;
#define KSWZ(row, colB) ((row) * 256 + ((colB) ^ (((row) & 7) << 4)))
#define SBAR() __builtin_amdgcn_sched_barrier(0)
__device__ __forceinline__ int crow(int r, int hi) { return (r & 3) + 8 * (r >> 2) + 4 * hi; }
__device__ __forceinline__ unsigned cvtpk(float lo, float hi) { unsigned r; asm volatile("v_cvt_pk_bf16_f32 %0, %1, %2" : "=v"(r) : "v"(lo), "v"(hi)); return r; }
__device__ __forceinline__ bf16x8 ld8(const bf16* p) { return *reinterpret_cast<const bf16x8*>(p); }

__device__ __forceinline__ void partialSM(f32x16& p0, f32x16& p1, float& m_reg, float& mn, float& alpha) {
  float pmax = p0[0]; for (int r = 1; r < 16; ++r) pmax = fmaxf(pmax, p0[r]); for (int r = 0; r < 16; ++r) pmax = fmaxf(pmax, p1[r]);
  { auto rr = __builtin_amdgcn_permlane32_swap(__float_as_uint(pmax), __float_as_uint(pmax), false, false);
    pmax = fmaxf(__uint_as_float(rr[0]), __uint_as_float(rr[1])); }
  if (__builtin_expect(__all(pmax - m_reg <= THR * 1.4426950408889634f), 1)) { mn = m_reg; alpha = 1.f; }
  else { mn = fmaxf(m_reg, pmax); alpha = __builtin_amdgcn_exp2f(m_reg - mn); m_reg = mn; }
  for (int r = 0; r < 16; ++r) p0[r] = p0[r] - mn; for (int r = 0; r < 16; ++r) p1[r] = p1[r] - mn;
  for (int r = 0; r < 16; ++r) p0[r] = __builtin_amdgcn_exp2f(p0[r]);
}
__device__ __forceinline__ void finishSM(f32x16& p0, f32x16& p1, float alpha, float& l_reg, bf16x8& pa0, bf16x8& pa1, bf16x8& pa2, bf16x8& pa3) {
  for (int r = 0; r < 16; ++r) p1[r] = __builtin_amdgcn_exp2f(p1[r]);
  float ps = 0; for (int r = 0; r < 16; ++r) ps += p0[r]; for (int r = 0; r < 16; ++r) ps += p1[r];
  { auto rr = __builtin_amdgcn_permlane32_swap(__float_as_uint(ps), __float_as_uint(ps), false, false);
    ps = __uint_as_float(rr[0]) + __uint_as_float(rr[1]); }
  l_reg = l_reg * alpha + ps;
#define PK4(P, BASE, OUT) do { unsigned a0 = cvtpk(P[BASE + 0], P[BASE + 1]), a1 = cvtpk(P[BASE + 2], P[BASE + 3]);   \
    unsigned b0 = cvtpk(P[BASE + 4], P[BASE + 5]), b1 = cvtpk(P[BASE + 6], P[BASE + 7]);                              \
    auto r0 = __builtin_amdgcn_permlane32_swap(a0, b0, false, false); auto r1 = __builtin_amdgcn_permlane32_swap(a1, b1, false, false); \
    u32x4 w = {r0[0], r1[0], r0[1], r1[1]}; OUT = *reinterpret_cast<bf16x8*>(&w); } while (0)
  PK4(p0, 0, pa0); PK4(p0, 8, pa1); PK4(p1, 0, pa2); PK4(p1, 8, pa3);
#undef PK4
}
__device__ __forceinline__ void partialSM_b(f32x16& p0, f32x16& p1) {
  for (int r = 0; r < 16; ++r) p0[r] = __builtin_amdgcn_exp2f(p0[r]);
}
__device__ __forceinline__ void qkt(f32x16& p0, f32x16& p1, const bf16* Ks, const bf16x8* qr, int r32, int hi) {
  p0 = f32x16{}; p1 = f32x16{};
  for (int d0 = 0; d0 < 8; ++d0) { int cb = (d0 * 16 + hi * 8) * 2;
    bf16x8 b0 = *reinterpret_cast<const bf16x8*>((const char*)Ks + KSWZ(r32, cb));
    bf16x8 b1 = *reinterpret_cast<const bf16x8*>((const char*)Ks + KSWZ(32 + r32, cb));
    p0 = __builtin_amdgcn_mfma_f32_32x32x16_bf16(b0, qr[d0], p0, 0, 0, 0);
    p1 = __builtin_amdgcn_mfma_f32_32x32x16_bf16(b1, qr[d0], p1, 0, 0, 0); }
}
__device__ __forceinline__ int v_st(int k, int c) { const int kk = (k & ~0xC) | ((k & 4) << 1) | ((k & 8) >> 1); return ((kk >> 3) * 4 + (c >> 5)) * 512 + ((kk & 7) * 32 + (c & 31)) * 2; }
__device__ __forceinline__ int v_rd_base(int lane) { return ((lane & 3) << 3) | (((lane >> 2) & 3) << 6) | (((lane >> 4) & 1) << 5) | (((lane >> 5) & 1) << 8); }
constexpr int v_rd_off(int d0, int ks, int half) { return d0 * 512 + ks * 4096 + half * 2048; }
template <int OFF> __device__ __forceinline__ s16x4 tr_read(int vb) {
  s16x4 r; asm volatile("ds_read_b64_tr_b16 %0, %1 offset:%2" : "=&v"(r) : "v"(vb), "i"(OFF) : "memory"); return r;
}
template <int D0> __device__ __forceinline__ void pv_one(f32x16& od, int vb, bf16x8 pa0, bf16x8 pa1, bf16x8 pa2, bf16x8 pa3) {
  const s16x4 l0 = tr_read<v_rd_off(D0, 0, 0)>(vb), h0 = tr_read<v_rd_off(D0, 0, 1)>(vb), l1 = tr_read<v_rd_off(D0, 1, 0)>(vb), h1 = tr_read<v_rd_off(D0, 1, 1)>(vb);
  const s16x4 l2 = tr_read<v_rd_off(D0, 2, 0)>(vb), h2 = tr_read<v_rd_off(D0, 2, 1)>(vb), l3 = tr_read<v_rd_off(D0, 3, 0)>(vb), h3 = tr_read<v_rd_off(D0, 3, 1)>(vb);
  asm volatile("s_waitcnt lgkmcnt(0)" ::: "memory"); SBAR();
#define PK(L, H) (bf16x8){L[0], L[1], L[2], L[3], H[0], H[1], H[2], H[3]}
  od = __builtin_amdgcn_mfma_f32_32x32x16_bf16(pa0, PK(l0, h0), od, 0, 0, 0);
  od = __builtin_amdgcn_mfma_f32_32x32x16_bf16(pa1, PK(l1, h1), od, 0, 0, 0);
  od = __builtin_amdgcn_mfma_f32_32x32x16_bf16(pa2, PK(l2, h2), od, 0, 0, 0);
  od = __builtin_amdgcn_mfma_f32_32x32x16_bf16(pa3, PK(l3, h3), od, 0, 0, 0);
#undef PK
}
__device__ __forceinline__ void pv_d0(f32x16* o, int vb, bf16x8 pa0, bf16x8 pa1, bf16x8 pa2, bf16x8 pa3) {
  pv_one<0>(o[0], vb, pa0, pa1, pa2, pa3); pv_one<1>(o[1], vb, pa0, pa1, pa2, pa3); pv_one<2>(o[2], vb, pa0, pa1, pa2, pa3); pv_one<3>(o[3], vb, pa0, pa1, pa2, pa3);
}

template <bool BOUNDED>
__device__ __forceinline__ void attn_dense_body(const bf16* __restrict__ Qb, const bf16* __restrict__ Kh, const bf16* __restrict__ Vh,
                                                unsigned short* __restrict__ Ob, int seq, char* lds) {
  const int tid = tid_l(), wid = tid >> 6, lane = tid & 63, r32 = lane & 31, hi = lane >> 5;
  bf16* V_lds = (bf16*)lds; bf16* K_lds = (bf16*)(lds + 2 * SHM_V);
  float* ws = (float*)(lds + 2 * SHM_V + 2 * SHM_K) + wid * 64; float* li_l = ws; float* al_l = ws + 32;
  float m_reg = -1e30f, l_reg = 0; f32x16 o[4] = {}; bf16x8 qr[8];
  const bf16* Qw = Qb + (long)(wid * QBLK + r32) * LDQ + hi * 8;
#pragma unroll
  for (int d0 = 0; d0 < 8; ++d0) qr[d0] = ld8(Qw + d0 * 16);
  const int sr = tid >> 4, sc = (tid & 15) * 8, vst0 = v_st(sr, sc), vst1 = v_st(32 + sr, sc);
  const int vb0 = (int)(uintptr_t)V_lds + v_rd_base(lane);
  struct { bf16x8 vs0, vs1, ks0, ks1; } sr_[SDEPTH];
  const unsigned vo0 = (unsigned)(sr * LDK + sc) * 2u, vo1 = vo0 + 32u * LDK * 2u;
#define SLOAD(i, k0) do { const char* kb_ = (const char*)Kh + (size_t)(k0) * (LDK * 2); const char* vb_ = (const char*)Vh + (size_t)(k0) * (LDK * 2); \
    sr_[i].vs0 = *(const bf16x8*)(vb_ + vo0); sr_[i].vs1 = *(const bf16x8*)(vb_ + vo1); sr_[i].ks0 = *(const bf16x8*)(kb_ + vo0); sr_[i].ks1 = *(const bf16x8*)(kb_ + vo1); } while (0)
#define SWRITE(b, i) do { *(bf16x8*)((char*)V_lds + (b) * SHM_V + vst0) = sr_[i].vs0;          \
    *(bf16x8*)((char*)V_lds + (b) * SHM_V + vst1) = sr_[i].vs1; int kc = sc * 2;               \
    *(bf16x8*)((char*)K_lds + (b) * SHM_K + KSWZ(sr, kc)) = sr_[i].ks0;                       \
    *(bf16x8*)((char*)K_lds + (b) * SHM_K + KSWZ(32 + sr, kc)) = sr_[i].ks1; } while (0)
#define SWAIT() do { asm volatile("s_waitcnt vmcnt(4)" ::: "memory"); } while (0)
#define RESC(a) do { if (__any((a) < 1.f)) { if (hi == 0) al_l[r32] = (a); asm volatile("s_waitcnt lgkmcnt(0)" ::: "memory"); \
    for (int d = 0; d < 4; ++d) for (int r = 0; r < 16; ++r) o[d][r] *= al_l[crow(r, hi)]; } } while (0)
#define PSM(P0, P1, MN, AL) do { if constexpr (BOUNDED) { partialSM_b(P0, P1); AL = 1.f; } else partialSM(P0, P1, m_reg, MN, AL); } while (0)
  f32x16 pA0, pA1, pB0, pB1; float mnA = 0.f, mnB = 0.f, alA = 1.f, alB = 1.f; bf16x8 pa0, pa1, pa2, pa3; int NT = seq / KVBLK; asm volatile("" : "+s"(NT));
  constexpr int SE = 0, SO = SDEPTH - 1;
  SLOAD(SE, 0); SLOAD(SO, KVBLK);
  SWAIT(); SWRITE(0, SE); __syncthreads();
  SLOAD(SE, 2 * KVBLK);
  qkt(pA0, pA1, K_lds, qr, r32, hi); PSM(pA0, pA1, mnA, alA);
  SWAIT(); SWRITE(1, SO); __syncthreads();
  for (int j = 1; j + 1 < NT; j += 2) {
    SBAR(); qkt(pB0, pB1, (bf16*)((char*)K_lds + SHM_K), qr, r32, hi);
    finishSM(pA0, pA1, alA, l_reg, pa0, pa1, pa2, pa3); SBAR();
    SLOAD(SO, (j + SDEPTH) * KVBLK); SBAR();
    pv_d0(o, vb0, pa0, pa1, pa2, pa3); PSM(pB0, pB1, mnB, alB);
    __syncthreads(); SWAIT(); SWRITE(0, SE);
    if constexpr (!BOUNDED) RESC(alB); __syncthreads();
    SBAR(); qkt(pA0, pA1, K_lds, qr, r32, hi);
    finishSM(pB0, pB1, alB, l_reg, pa0, pa1, pa2, pa3); SBAR();
    SLOAD(SE, ((j + 3 < NT) ? (j + 1 + SDEPTH) : (NT - 1)) * KVBLK); SBAR();
    pv_d0(o, vb0 + (int)SHM_V, pa0, pa1, pa2, pa3); PSM(pA0, pA1, mnA, alA);
    __syncthreads(); SWAIT(); SWRITE(1, SO);
    if constexpr (!BOUNDED) RESC(alA); __syncthreads();
  }
  SBAR(); qkt(pB0, pB1, (bf16*)((char*)K_lds + SHM_K), qr, r32, hi);
  finishSM(pA0, pA1, alA, l_reg, pa0, pa1, pa2, pa3); SBAR();
  pv_d0(o, vb0, pa0, pa1, pa2, pa3); PSM(pB0, pB1, mnB, alB);
  __syncthreads(); if constexpr (!BOUNDED) RESC(alB);
  finishSM(pB0, pB1, alB, l_reg, pa0, pa1, pa2, pa3); SBAR();
  pv_d0(o, vb0 + (int)SHM_V, pa0, pa1, pa2, pa3);
  if (hi == 0) li_l[r32] = l_reg; asm volatile("s_waitcnt lgkmcnt(0)" ::: "memory");
  float rli[16];
#pragma unroll
  for (int r = 0; r < 16; ++r) rli[r] = __builtin_amdgcn_rcpf(li_l[crow(r, hi)]);
  unsigned short* Ow = Ob + (long)(wid * QBLK) * LDO;
  const int odd = lane & 1;
#pragma unroll
  for (int r = 0; r < 16; r += 2) { const int orow = crow(r + odd, hi);
#pragma unroll
    for (int d0 = 0; d0 < 4; ++d0) { const float a = o[d0][r] * rli[r], b = o[d0][r + 1] * rli[r + 1];
      const float send = odd ? a : b; const float recv = __shfl_xor(send, 1);
      const unsigned w = odd ? cvtpk(recv, b) : cvtpk(a, recv);
      *(unsigned*)(Ow + (long)orow * LDO + d0 * 32 + (r32 & ~1)) = w; } }
  __syncthreads();
#undef SLOAD
#undef SWRITE
#undef SWAIT
#undef RESC
#undef PSM
}
#undef KSWZ
#undef SBAR
}

#define LAS __attribute__((address_space(3)))
typedef unsigned short bf16;
typedef unsigned v4u __attribute__((ext_vector_type(4)));
typedef unsigned v2u __attribute__((ext_vector_type(2)));
typedef float f32x4 __attribute__((ext_vector_type(4)));
#define LDS_WAIT() asm volatile("s_waitcnt lgkmcnt(0)" ::: "memory")
__device__ __forceinline__ unsigned f2bf(float f) { unsigned u = __builtin_bit_cast(unsigned, f); return (u + 0x7fffu + ((u >> 16) & 1u)) >> 16; }
__device__ __forceinline__ unsigned pk2(float lo, float hi) { return f2bf(lo) | (f2bf(hi) << 16); }
__device__ __forceinline__ float bf_lo(unsigned w) { return __builtin_bit_cast(float, w << 16); }
__device__ __forceinline__ float bf_hi(unsigned w) { return __builtin_bit_cast(float, w & 0xffff0000u); }
__device__ __forceinline__ float wave_sum(float v) {
#pragma unroll
    for (int o = 1; o < 64; o <<= 1) v += __shfl_xor(v, o);
    return v;
}

struct Args { const float* in[13]; float* out; unsigned char* ws; int ph_lo, ph_hi; };
typedef const Args __attribute__((address_space(4)))* KArgs;

__device__ __forceinline__ int map_src_col(int mode, int n) {
    if (mode == 1) { const int pn = n >> 8, w = n & 255; return w < 128 ? pn * 128 + w : DFF + pn * 128 + (w - 128); }
    if (mode == 2) { if (n >= 1280) return n; const int h = n >> 7, d = n & 127, half = d >> 6, dd = d & 63; return h * 128 + half * 64 + (dd >> 1) + 32 * (dd & 1); }
    return n;
}
__device__ __forceinline__ void transpose_item(const float* W, int K, int N, bf16* WT, const float* gain, int mode, LAS float* scr, int item, int lane) {
    const int nblk = N / 32, kb = item / nblk, nb = item % nblk, k0 = 64 * kb, n0 = 32 * nb;
    const int srcc = map_src_col(mode, n0 + (lane & 31));
    float wv[32];
#pragma unroll
    for (int i = 0; i < 32; ++i) wv[i] = W[(size_t)(k0 + 2 * i + (lane >> 5)) * N + srcc];
#pragma unroll
    for (int i = 0; i < 32; ++i) { const int kk = 2 * i + (lane >> 5); float v = wv[i]; if (gain) v *= gain[k0 + kk]; scr[kk * 33 + (lane & 31)] = v; }
    LDS_WAIT(); asm volatile("" ::: "memory");
    const int c = lane & 7;
#pragma unroll
    for (int j = 0; j < 4; ++j) { const int n = (lane >> 3) + 8 * j; const LAS float* s = scr + (8 * c) * 33 + n;
        v4u o; o.x = pk2(s[0 * 33], s[1 * 33]); o.y = pk2(s[2 * 33], s[3 * 33]); o.z = pk2(s[4 * 33], s[5 * 33]); o.w = pk2(s[6 * 33], s[7 * 33]);
        *(v4u*)(WT + (size_t)(n0 + n) * K + k0 + 8 * c) = o; }
    LDS_WAIT(); asm volatile("" ::: "memory");
}

__device__ __forceinline__ void p0_prologue(KArgs a, LAS unsigned char* lds, int gw, int NGW, int wave, int lane) {
    unsigned char* ws = a->ws;
    LAS float* scr = (LAS float*)(lds + wave * 16384);
    const float* norm_mix = a->in[2]; const float* norm_ffn = a->in[3]; const float* pool_w = a->in[4];
    const float* w_qkv = a->in[7]; const float* w_o = a->in[10]; const float* w_gu = a->in[11]; const float* w_d = a->in[12];
    const float* x0 = a->in[0]; const float* x1 = a->in[1];
    constexpr int I_GU = (DM / 64) * (NGU / 32), I_D = (DFF / 64) * (DM / 32), I_QKV = (DM / 64) * (NQKV / 32), I_O = (DM / 64) * (DM / 32), I_P = (256 / 64) * (256 / 32);
    constexpr int NITEMS = 4 * I_GU + 4 * I_D + 2 * I_QKV + 2 * I_O + 8 * I_P;
    for (int it = gw; it < NITEMS; it += NGW) {
        int r = it;
        if (r < 4 * I_GU) { const int l = r / I_GU; r -= l * I_GU; transpose_item(w_gu + (size_t)l * DM * NGU, DM, NGU, (bf16*)(ws + WS_WGU) + (size_t)l * NGU * DM, norm_ffn + l * DM, 1, scr, r, lane); continue; } r -= 4 * I_GU;
        if (r < 4 * I_D) { const int l = r / I_D; r -= l * I_D; transpose_item(w_d + (size_t)l * DFF * DM, DFF, DM, (bf16*)(ws + WS_WD) + (size_t)l * DM * DFF, nullptr, 0, scr, r, lane); continue; } r -= 4 * I_D;
        if (r < 2 * I_QKV) { const int l = r / I_QKV; r -= l * I_QKV; transpose_item(w_qkv + (size_t)l * DM * NQKV, DM, NQKV, (bf16*)(ws + WS_WQKV) + (size_t)l * NQKV * DM, norm_mix + (2 * l + 1) * DM, 2, scr, r, lane); continue; } r -= 2 * I_QKV;
        if (r < 2 * I_O) { const int l = r / I_O; r -= l * I_O; transpose_item(w_o + (size_t)l * DM * DM, DM, DM, (bf16*)(ws + WS_WO) + (size_t)l * DM * DM, nullptr, 0, scr, r, lane); continue; } r -= 2 * I_O;
        { const int l = r / I_P; r -= l * I_P; transpose_item(pool_w + (size_t)l * 256 * 256, 256, 256, (bf16*)(ws + WS_WP) + (size_t)l * 256 * 256, nullptr, 0, scr, r, lane); }
    }
    for (int e = gw * 64 + lane; e < 64 * 32; e += NGW * 64) { const int pos = e >> 5, i = e & 31;
        const float inv = exp2f(-(float)(2 * i) * (1.0f / 64.0f) * 13.287712379549449f);
        const float ang = (float)pos * inv; float rev = ang * 0.15915494309189535f; rev -= floorf(rev);
        float2 cs; cs.x = __builtin_amdgcn_cosf(rev); cs.y = __builtin_amdgcn_sinf(rev);
        ((float2*)(ws + WS_ROPE))[e] = cs; }
    if (gw < 2) { const float* qg = a->in[8] + gw * HD; const float* kg = a->in[9] + gw * HD;
        float mq = fmaxf(fabsf(qg[lane]), fabsf(qg[lane + 64])), mk = fmaxf(fabsf(kg[lane]), fabsf(kg[lane + 64]));
#pragma unroll
        for (int o = 1; o < 64; o <<= 1) { mq = fmaxf(mq, __shfl_xor(mq, o)); mk = fmaxf(mk, __shfl_xor(mk, o)); }
        if (lane == 0) ((float*)(ws + WS_BOUND))[gw] = 11.313708498984761f * mq * mk * 1.02f; }
    { pg8::ss_t* ss = (pg8::ss_t*)(ws + WS_SS); for (size_t e = (size_t)gw * 64 + lane + M_TOT; e < (size_t)8 * M_TOT; e += (size_t)NGW * 64) ss[e] = 0ull; }
    { pg8::ss_t* ss = (pg8::ss_t*)(ws + WS_SS);
      for (int m = gw; m < M_TOT; m += 2 * NGW) { const int m2 = m + NGW;
          const bool has2 = m2 < M_TOT; const int mb = has2 ? m2 : m;
          const float* xa = (m < 4 * SEQ) ? x0 + (size_t)m * DM : x1 + (size_t)(m - 4 * SEQ) * DM; const float* xb_ = (mb < 4 * SEQ) ? x0 + (size_t)mb * DM : x1 + (size_t)(mb - 4 * SEQ) * DM;
          const f32x4* a4 = (const f32x4*)xa + lane; const f32x4* b4 = (const f32x4*)xb_ + lane; f32x4 va[4], vb[4];
#pragma unroll
          for (int j = 0; j < 4; ++j) { va[j] = a4[64 * j]; vb[j] = b4[64 * j]; }
          float sa = 0.f, sb = 0.f;
#pragma unroll
          for (int j = 0; j < 4; ++j) { sa += (va[j].x * va[j].x + va[j].y * va[j].y) + (va[j].z * va[j].z + va[j].w * va[j].w); sb += (vb[j].x * vb[j].x + vb[j].y * vb[j].y) + (vb[j].z * vb[j].z + vb[j].w * vb[j].w); }
          { bf16* xo = (bf16*)(ws + WS_XB);
#pragma unroll
            for (int j = 0; j < 4; ++j) { v2u wa; wa.x = pk2(va[j].x, va[j].y); wa.y = pk2(va[j].z, va[j].w); *(v2u*)(xo + (size_t)m * DM + (64 * j + lane) * 4) = wa;
                                          v2u wb; wb.x = pk2(vb[j].x, vb[j].y); wb.y = pk2(vb[j].z, vb[j].w); if (has2) *(v2u*)(xo + (size_t)m2 * DM + (64 * j + lane) * 4) = wb; } }
          sa = wave_sum(sa); sb = wave_sum(sb); if (lane == 0) { ss[m] = pg8::ss_fix(sa); if (has2) ss[m2] = pg8::ss_fix(sb); } } }
}

template <bool F32IN, int GI>
__device__ __forceinline__ void pool_item(const float* xf, const bf16* xb, const pg8::ss_t* ss, const float* g, bf16* P, int t0, int lane) {
    constexpr int HW = 1 << GI, W = 2 * HW, NR = 15 + W, ELT = F32IN ? 4 : 2;
    const int bstart = t0 & ~(SEQ - 1), c = GI * 256 + lane * 4;
    float myrs; { const int myrow = t0 - HW + lane, myrc = min(max(myrow, bstart), bstart + SEQ - 1);
        myrs = (myrow == myrc) ? pg8::ss_rsqrt(ss, myrc) : 0.f; }
    f32x4 r[NR];
    int rc = max(t0 - HW, bstart);
    const char* p = (const char*)(F32IN ? (const void*)xf : (const void*)xb) + ((size_t)rc * DM + c) * ELT;
#pragma unroll
    for (int k = 0; k < NR; ++k) {
        if (F32IN) r[k] = *(const f32x4*)p;
        else { const v2u w = *(const v2u*)p; r[k] = (f32x4){bf_lo(w.x), bf_hi(w.x), bf_lo(w.y), bf_hi(w.y)}; }
        const int rcn = min(max(t0 - HW + k + 1, bstart), bstart + SEQ - 1);
        p += (size_t)(rcn - rc) * (DM * ELT); rc = rcn; asm volatile("" : "+v"(p)); }
    const f32x4 g4 = *(const f32x4*)(g + c);
#pragma unroll
    for (int k = 0; k < NR; ++k) r[k] = r[k] * __builtin_bit_cast(float, __builtin_amdgcn_readlane(__builtin_bit_cast(int, myrs), k));
    f32x4 S = r[0];
#pragma unroll
    for (int k = 1; k < W; ++k) S += r[k];
    bf16* q = P + (size_t)t0 * DM + c;
#pragma unroll
    for (int tt = 0; tt < 16; ++tt) { const int tl = t0 + tt - bstart; const int cnt = min(tl + HW, SEQ) - max(tl - HW, 0);
        const f32x4 p4 = (S * (1.0f / (float)cnt) - r[tt + HW]) * g4;
        v2u w; w.x = pk2(p4.x, p4.y); w.y = pk2(p4.z, p4.w);
        *(v2u*)q = w; q += DM; asm volatile("" : "+v"(q));
        if (tt < 15) S += r[tt + W] - r[tt]; }
}
template <bool F32IN, int GI>
__device__ __forceinline__ void pool_loop(const float* x0, const float* x1, const bf16* xb, const pg8::ss_t* ss, const float* g, bf16* P, int gw, int NGW, int lane) {
    const int nitems = (M_TOT / 16) * 4;
    for (int it = gw; it < nitems; it += NGW) { const int t0 = (it >> 2) * 16;
        const float* xf = F32IN ? ((t0 < 4 * SEQ) ? x0 : x1 - (size_t)4 * SEQ * DM) : nullptr;
        pool_item<F32IN, GI>(xf, xb, ss, g, P, t0, lane); }
}
template <bool F32IN>
__device__ __forceinline__ void pool_prep(const float* x0, const float* x1, const bf16* xb, const pg8::ss_t* ss, const float* g, bf16* P, int gw, int NGW, int lane) {
    const int gi = gw & 3;
    if (gi == 0) pool_loop<F32IN, 0>(x0, x1, xb, ss, g, P, gw, NGW, lane);
    else if (gi == 1) pool_loop<F32IN, 1>(x0, x1, xb, ss, g, P, gw, NGW, lane);
    else if (gi == 2) pool_loop<F32IN, 2>(x0, x1, xb, ss, g, P, gw, NGW, lane);
    else pool_loop<F32IN, 3>(x0, x1, xb, ss, g, P, gw, NGW, lane);
}

#define XB_TMO      128
#define XB_XCNT(j)  (256  + 64 * (j))
#define XB_XSUB(j)  (1280 + 64 * (j))
#define XB_XGEN(j)  (2304 + 64 * (j))
#define XB_TOP      3328
#define XB_TOPGEN   3392
#define XCD_BAR_WORDS 3456
#define XB_SPIN_CAP (1u << 18)
__device__ __forceinline__ unsigned xb_ld(unsigned* p)              { return __hip_atomic_load(p, __ATOMIC_RELAXED, __HIP_MEMORY_SCOPE_AGENT); }
__device__ __forceinline__ unsigned xb_add(unsigned* p, unsigned v) { return __hip_atomic_fetch_add(p, v, __ATOMIC_RELAXED, __HIP_MEMORY_SCOPE_AGENT); }
__device__ __forceinline__ unsigned xb_xcc_id() { return (unsigned)__builtin_amdgcn_s_getreg((3 << 11) | 20) & 0xFu; }
#define XB_SPIN(cond, bar) do { unsigned _sp = 0; while (cond) { __builtin_amdgcn_s_sleep(1); \
    if ((++_sp & 255u) == 0u) { if (xb_ld(&(bar)[XB_TMO])) break; if (_sp > XB_SPIN_CAP) { atomicAdd(&(bar)[XB_TMO], 1u); break; } } } } while (0)
__device__ __forceinline__ void xcd_barrier_complete(unsigned* bar, unsigned x, unsigned& nloc, unsigned& nx) {
    const unsigned G = gridDim.x * gridDim.y * gridDim.z;
    unsigned sum, cnt, mine, sp = 0u;
    for (;;) {
        sum = 0u; cnt = 0u; mine = 0u;
#pragma unroll
        for (unsigned j = 0; j < 16; ++j) { const unsigned c = xb_ld(&bar[XB_XCNT(j)]); sum += c; cnt += (c > 0u) ? 1u : 0u; mine = (j == x) ? c : mine; }
        if (sum == G) break;
        __builtin_amdgcn_s_sleep(1);
        if ((++sp & 255u) == 0u) { if (xb_ld(&bar[XB_TMO])) break; if (sp > XB_SPIN_CAP) { atomicAdd(&bar[XB_TMO], 1u); break; } }
    }
    nloc = mine > 0u ? mine : 1u; nx = cnt > 0u ? cnt : 1u;
}
__device__ __forceinline__ void xcd_barrier(unsigned* bar, volatile LAS unsigned* st) {
    asm volatile("s_waitcnt vmcnt(0)" ::: "memory");
    __syncthreads();
    if (threadIdx.x == 0) {
        const unsigned x = xb_xcc_id();
        __builtin_amdgcn_s_waitcnt(0);
        unsigned nloc = st[0], nx = st[1];
        if (nloc == 0u) { xcd_barrier_complete(bar, x, nloc, nx); st[0] = nloc; st[1] = nx; }
        const unsigned old = xb_add(&bar[XB_XSUB(x)], 1u);
        const unsigned gen = old / nloc;
        if (old + 1u == (gen + 1u) * nloc) {
            __builtin_amdgcn_fence(__ATOMIC_RELEASE, "agent");
            asm volatile("s_waitcnt vmcnt(0)" ::: "memory");
            const unsigned og = xb_add(&bar[XB_TOP], 1u);
            const unsigned tg = og / nx;
            if (og + 1u == (tg + 1u) * nx) xb_add(&bar[XB_TOPGEN], 1u);
            else XB_SPIN(xb_ld(&bar[XB_TOPGEN]) == tg, bar);
            __builtin_amdgcn_fence(__ATOMIC_ACQUIRE, "agent");
            xb_add(&bar[XB_XGEN(x)], 1u);
            asm volatile("s_waitcnt vmcnt(0)" ::: "memory");
        } else {
            XB_SPIN(xb_ld(&bar[XB_XGEN(x)]) == gen, bar);
            __builtin_amdgcn_fence(__ATOMIC_ACQUIRE, "agent");
            asm volatile("s_waitcnt vmcnt(0)" ::: "memory");
        }
    }
    __syncthreads();
}

__device__ __forceinline__ KArgs kargs() { KArgs p = (KArgs)__builtin_amdgcn_kernarg_segment_ptr(); asm volatile("" : "+s"(p)); return p; }
struct Ctx { int G, bx, vcu, gw, NGW, wave, lane; };
__device__ __forceinline__ Ctx ctx() { Ctx c; const int tid = tid_l(); c.lane = tid & 63; c.wave = __builtin_amdgcn_readfirstlane(tid >> 6); c.G = gridDim.x; c.bx = blockIdx.x;
    c.vcu = (c.G % 8 == 0) ? (c.bx % 8) * (c.G / 8) + c.bx / 8 : c.bx;
    c.gw = c.vcu * NWAVES + c.wave; c.NGW = c.G * NWAVES; return c; }

__device__ __forceinline__ void ph_prologue(LAS unsigned char* L) { KArgs ka = kargs(); const Ctx c = ctx(); p0_prologue(ka, L, c.gw, c.NGW, c.wave, c.lane); }
__device__ __forceinline__ void ph_pool_prep(int layer) { KArgs ka = kargs(); const Ctx c = ctx(); unsigned char* ws = ka->ws;
    const pg8::ss_t* ss_mix = (const pg8::ss_t*)(ws + WS_SS) + (size_t)(2 * layer) * M_TOT;
    pool_prep<false>(nullptr, nullptr, (const bf16*)(ws + WS_XB), ss_mix, ka->in[2] + layer * DM, (bf16*)(ws + WS_P), c.gw, c.NGW, c.lane); }
__device__ __forceinline__ void ph_qkv(LAS unsigned char* L, int layer) { KArgs ka = kargs(); const Ctx c = ctx(); unsigned char* ws = ka->ws; const int j = layer >> 1;
    pg8::Gemm g{(const bf16*)(ws + WS_XB), (const bf16*)(ws + WS_WQKV) + (size_t)j * NQKV * DM, M_TOT, NQKV, DM, DM, DM, 0}; pg8::StaticOrder S; S.init(M_TOT, NQKV, c.G, c.bx);
    pg8::EpiQKV E{(bf16*)(ws + WS_QKV), (bf16*)(ws + WS_KC), (bf16*)(ws + WS_VC), (const pg8::ss_t*)(ws + WS_SS) + (size_t)(2 * layer) * M_TOT, ka->in[8] + j * HD, ka->in[9] + j * HD, (const LAS float*)(L + 131072 + 10240), (LAS float*)(L + 131072 + 1024)};
    { const int tid = tid_l(); const v4u* src = (const v4u*)(ws + WS_ROPE); LAS v4u* dst = (LAS v4u*)(L + 131072 + 10240);
      dst[tid] = src[tid]; dst[tid + 512] = src[tid + 512]; LDS_WAIT(); }
    pg8::gemm_phase<pg8::EpiQKV, pg8::StaticOrder>(L, g, S, E);
}
__device__ __forceinline__ void ph_attn(unsigned char* lds, int layer) { KArgs ka = kargs(); const Ctx c = ctx(); unsigned char* ws = ka->ws;
    const float bound = ((const float*)(ws + WS_BOUND))[layer >> 1]; const bool bounded = bound < 40.f;
    bf16* QB = (bf16*)(ws + WS_QKV); bf16* KC = (bf16*)(ws + WS_KC); bf16* VC = (bf16*)(ws + WS_VC); bf16* OB = (bf16*)(ws + WS_O);
    for (int U = c.vcu; U < NB_TOT * 2 * 64; U += c.G) {
        int grp, uu;
        if (c.G == 256) { const int i = U >> 8, xcd = c.vcu >> 5, loc = c.vcu & 31; grp = xcd + 8 * (i >> 1); uu = (i & 1) * 32 + loc; }
        else { grp = U >> 6; uu = U & 63; }
        const int b = grp >> 1, kvh = grp & 1, head = kvh * 4 + (uu >> 4), qb = uu & 15;
        const size_t rowb = (size_t)b * SEQ, row0 = rowb + (size_t)qb * 256;
        if (bounded) attn::attn_dense_body<true>((const attn::bf16*)(QB + row0 * DM + head * HD), (const attn::bf16*)(KC + (size_t)grp * SEQ * HD),
                              (const attn::bf16*)(VC + (size_t)grp * SEQ * HD), OB + row0 * DM + head * HD, SEQ, (char*)lds);
        else attn::attn_dense_body<false>((const attn::bf16*)(QB + row0 * DM + head * HD), (const attn::bf16*)(KC + (size_t)grp * SEQ * HD),
                              (const attn::bf16*)(VC + (size_t)grp * SEQ * HD), OB + row0 * DM + head * HD, SEQ, (char*)lds);
    } }
__device__ __forceinline__ void ph_mix(LAS unsigned char* L, int layer) { KArgs ka = kargs(); const Ctx c = ctx(); unsigned char* ws = ka->ws; const int j = layer >> 1;
    pg8::Gemm g; const float* mbias = nullptr; const float* mscale = nullptr;
    if ((layer & 1) == 0) { g = pg8::Gemm{(const bf16*)(ws + WS_P), (const bf16*)(ws + WS_WP) + (size_t)j * DM * 256, M_TOT, DM, 256, DM, 256, 256}; mbias = ka->in[5] + j * DM; mscale = ka->in[6] + j * DM; }
    else g = pg8::Gemm{(const bf16*)(ws + WS_O), (const bf16*)(ws + WS_WO) + (size_t)j * DM * DM, M_TOT, DM, DM, DM, DM, 0};
    pg8::StaticOrder S; S.init(M_TOT, DM, c.G, c.bx);
    const float* b_lo = nullptr; const float* b_hi = nullptr;
    pg8::EpiRes E{b_lo, b_hi, 4 * SEQ / 256, nullptr, (bf16*)(ws + WS_XB), (pg8::ss_t*)(ws + WS_SS) + (size_t)(2 * layer + 1) * M_TOT, mbias, mscale};
    pg8::gemm_phase<pg8::EpiRes, pg8::StaticOrder>(L, g, S, E);
}
__device__ __forceinline__ void ph_gateup(LAS unsigned char* L, int layer) { KArgs ka = kargs(); const Ctx c = ctx(); unsigned char* ws = ka->ws;
    pg8::Gemm g{(const bf16*)(ws + WS_XB), (const bf16*)(ws + WS_WGU) + (size_t)layer * NGU * DM, M_TOT, NGU, DM, DM, DM, 0}; pg8::StaticOrder S; S.init(M_TOT, NGU, c.G, c.bx);
    pg8::EpiSwiGLU E{(bf16*)(ws + WS_H), (const pg8::ss_t*)(ws + WS_SS) + (size_t)(2 * layer + 1) * M_TOT};
    pg8::gemm_phase<pg8::EpiSwiGLU, pg8::StaticOrder>(L, g, S, E);
}
__device__ __forceinline__ void ph_down(LAS unsigned char* L, int layer) { KArgs ka = kargs(); const Ctx c = ctx(); unsigned char* ws = ka->ws;
    pg8::Gemm g{(const bf16*)(ws + WS_H), (const bf16*)(ws + WS_WD) + (size_t)layer * DM * DFF, M_TOT, DM, DFF, DFF, DFF, 0}; pg8::StaticOrder S; S.init(M_TOT, DM, c.G, c.bx);
    pg8::EpiRes E{nullptr, nullptr, 0, (layer < 3) ? nullptr : ka->out, (bf16*)(ws + WS_XB), (layer < 3) ? (pg8::ss_t*)(ws + WS_SS) + (size_t)(2 * layer + 2) * M_TOT : nullptr, nullptr, nullptr};
    pg8::gemm_phase<pg8::EpiRes, pg8::StaticOrder>(L, g, S, E);
}

__global__ void __launch_bounds__(NWAVES * 64, 2) mk_fwd(Args args) {
    extern __shared__ __attribute__((aligned(16))) unsigned char lds[];
    cg::grid_group grid = cg::this_grid();
    LAS unsigned char* L = (LAS unsigned char*)lds;
    const int lo = args.ph_lo, hi = args.ph_hi;
    if (threadIdx.x < 2) ((volatile LAS unsigned*)(L + 131072 + 256))[threadIdx.x] = 0u;
    __syncthreads();
    if (MK_N_LAUNCHES == 1 && threadIdx.x == 0) (void)xb_add((unsigned*)(args.ws + WS_BAR) + XB_XCNT(xb_xcc_id()), 1u);
#define RUN(k) (lo <= (k) && (k) < hi)
#define SEAM(k) do { if (RUN(k) && RUN((k) + 1)) { KArgs ka_ = kargs(); xcd_barrier((unsigned*)(ka_->ws + WS_BAR), (volatile LAS unsigned*)(L + 131072 + 256)); } } while (0)
    int ph = 0;
    if (RUN(ph)) ph_prologue(L);
    if (args.ph_lo < -1) grid.sync();
    SEAM(ph);
    ++ph;
    for (int layer = 0; layer < 4; ++layer) {
        if ((layer & 1) == 0) {
            if (RUN(ph)) ph_pool_prep(layer);
            SEAM(ph); ++ph;
        } else {
            if (RUN(ph)) ph_qkv(L, layer);
            SEAM(ph); ++ph;
            if (RUN(ph)) ph_attn(lds, layer);
            SEAM(ph); ++ph;
        }
        if (RUN(ph)) ph_mix(L, layer);
        SEAM(ph); ++ph;
        if (RUN(ph)) ph_gateup(L, layer);
        SEAM(ph); ++ph;
        if (RUN(ph)) ph_down(L, layer);
        SEAM(ph); ++ph;
    }
#undef RUN
#undef SEAM
}

extern "C" void kernel_launch(void* const* d_in, const int* in_sizes, int n_in, void* d_out, int out_size, void* d_ws, size_t ws_size, hipStream_t stream) {
    static int grid = 0;
    if (grid == 0) {
        if (n_in != 13 || in_sizes[0] != 4 * SEQ * DM || in_sizes[1] != 8 * SEQ * DM || out_size != M_TOT * DM || ws_size < WS_END) {
            fprintf(stderr, "kernel_launch: shape mismatch n_in %d in0 %d in1 %d out %d ws %zu\n", n_in, n_in > 0 ? in_sizes[0] : -1, n_in > 1 ? in_sizes[1] : -1, out_size, ws_size); grid = -1; return; }
        int dev = 0, cus = 0, per_cu = 0;
        if (hipGetDevice(&dev) != hipSuccess || hipDeviceGetAttribute(&cus, hipDeviceAttributeMultiprocessorCount, dev) != hipSuccess) { grid = -1; return; }
        if (hipFuncSetAttribute((const void*)mk_fwd, hipFuncAttributeMaxDynamicSharedMemorySize, LDS_BYTES) != hipSuccess) { fprintf(stderr, "kernel_launch: hipFuncSetAttribute failed\n"); grid = -1; return; }
        if (hipOccupancyMaxActiveBlocksPerMultiprocessor(&per_cu, (const void*)mk_fwd, NWAVES * 64, LDS_BYTES) != hipSuccess || per_cu < 1) { fprintf(stderr, "kernel_launch: occupancy query says %d\n", per_cu); per_cu = 1; }
        (void)hipGetLastError();
        grid = cus * (per_cu > 1 ? 1 : per_cu);
    }
    if (grid < 0) return;
    if (hipMemsetAsync((char*)d_ws + WS_BAR, 0, 16384, stream) != hipSuccess) { fprintf(stderr, "kernel_launch: memset of the barrier words failed\n"); return; }
    Args a{};
    for (int i = 0; i < 13; ++i) a.in[i] = (const float*)d_in[i];
    a.out = (float*)d_out; a.ws = (unsigned char*)d_ws;
#if MK_N_LAUNCHES == 1
    a.ph_lo = 0; a.ph_hi = N_PHASES;
    void* kargs[] = {&a};
    hipError_t e = hipLaunchCooperativeKernel((const void*)mk_fwd, dim3(grid), dim3(NWAVES * 64), kargs, LDS_BYTES, stream);
    if (e != hipSuccess) fprintf(stderr, "kernel_launch: cooperative launch failed: %s (grid %d)\n", hipGetErrorString(e), grid);
#else
    for (int p = 0; p < N_PHASES; ++p) { a.ph_lo = p; a.ph_hi = p + 1;
        hipLaunchKernelGGL(mk_fwd, dim3(grid), dim3(NWAVES * 64), LDS_BYTES, stream, a);
        const hipError_t le = hipPeekAtLastError();
        if (le != hipSuccess) { fprintf(stderr, "kernel_launch: launch %d failed: %s\n", p, hipGetErrorName(le)); break; } }
#endif
}
```
